# Optimizing an MI355X kernel written in HIP

```python
import math
import jax
import jax.numpy as jnp
from jax import lax
import numpy as np

D_MODEL = 1024
BATCH = 4
SEQ = 8192
DEPTH = 4

GRID_W = 64
CTX_LEN = 256
N_MIXERS = 3
Q_BLOCK = 128
ROPE_THETA = 10000.0
NORM_EPS = 1e-6

A_HEAD_DIM = 64
A_HEADS = D_MODEL // (2 * A_HEAD_DIM)
B_HEADS = D_MODEL // 64
B_NOPE = 64
B_ROPE = 32
B_VDIM = 64
B_Q_LORA = D_MODEL // 4
B_KV_LORA = D_MODEL // 4
C_HEAD_DIM = 64
C_HEADS = D_MODEL // C_HEAD_DIM
NA_ROWS_MAX = 8
NA_COLS = 16
FFN_HIDDEN = ((8 * D_MODEL + 3 * 256 - 1) // (3 * 256)) * 256

kernel_name = 'hybrid_diff_mla_natten_dit_block'


def rmsnorm(x, g):
    xf = x.astype(jnp.float32)
    y = xf * lax.rsqrt(jnp.mean(xf * xf, axis=-1, keepdims=True) + NORM_EPS)
    return (y * g.astype(jnp.float32)).astype(x.dtype)


def swiglu(h, w_gu, w_down):
    g, u = jnp.split(h @ w_gu, 2, axis=-1)
    return (jax.nn.silu(g) * u) @ w_down


def lambda_init(layer_idx):
    return 0.8 - 0.6 * math.exp(-0.3 * layer_idx)


def axial_rope_tables(n_tokens, rot_dim):
    n_freq = rot_dim // 4
    inv = ROPE_THETA ** (-jnp.arange(n_freq, dtype=jnp.float32) / n_freq)
    t = jnp.arange(n_tokens, dtype=jnp.int32)
    row = (t // GRID_W).astype(jnp.float32)
    col = (t % GRID_W).astype(jnp.float32)
    ang = jnp.concatenate([row[:, None] * inv, col[:, None] * inv], axis=-1)
    return jnp.cos(ang), jnp.sin(ang)


def apply_rope(t, cos, sin):
    half = t.shape[-1] // 2
    tf = t.astype(jnp.float32)
    t1, t2 = tf[..., :half], tf[..., half:]
    cs, sn = cos[None, :, None, :], sin[None, :, None, :]
    return jnp.concatenate([t1 * cs - t2 * sn, t1 * sn + t2 * cs], axis=-1).astype(t.dtype)


def sweep_query_blocks(fn, qs):
    Bn, S = qs[0].shape[:2]
    nb = S // Q_BLOCK
    qb = tuple(q.reshape((Bn, nb, Q_BLOCK) + q.shape[2:]).swapaxes(0, 1) for q in qs)
    out = lax.map(lambda a: fn(*a), qb)
    return out.swapaxes(0, 1).reshape((Bn, S) + out.shape[3:])


def diff_attention_mixer(h_lat, h_ctx, w_qkv, w_o, lam_vecs, g_sub, lam_init, cos, sin, with_ctx_out):
    H, d = A_HEADS, A_HEAD_DIM
    scale = d ** -0.5

    def project(h):
        Bn, T, _ = h.shape
        q, k, v = jnp.split(h @ w_qkv, 3, axis=-1)
        q = q.reshape(Bn, T, H, 2, d)
        k = k.reshape(Bn, T, H, 2, d)
        v = v.reshape(Bn, T, H, 2 * d)
        return q[:, :, :, 0], q[:, :, :, 1], k[:, :, :, 0], k[:, :, :, 1], v

    lf = lam_vecs.astype(jnp.float32)
    lam = jnp.exp(jnp.sum(lf[0] * lf[1])) - jnp.exp(jnp.sum(lf[2] * lf[3])) + lam_init

    q1l, q2l, k1l, k2l, vl = project(h_lat)
    q1l, q2l, k1l, k2l = (apply_rope(t, cos, sin) for t in (q1l, q2l, k1l, k2l))
    q1c, q2c, k1c, k2c, vc = project(h_ctx)
    k1 = jnp.concatenate([k1c, k1l], axis=1)
    k2 = jnp.concatenate([k2c, k2l], axis=1)
    v = jnp.concatenate([vc, vl], axis=1)

    def attend(q1, q2, ka, kb, vv):
        s1 = jnp.einsum('bqhd,bkhd->bhqk', q1, ka).astype(jnp.float32) * scale
        s2 = jnp.einsum('bqhd,bkhd->bhqk', q2, kb).astype(jnp.float32) * scale
        p = jax.nn.softmax(s1, axis=-1) - lam * jax.nn.softmax(s2, axis=-1)
        return jnp.einsum('bhqk,bkhe->bqhe', p.astype(vv.dtype), vv)

    def finish(o):
        o = rmsnorm(o, g_sub) * (1.0 - lam_init)
        return o.reshape(o.shape[:2] + (H * 2 * d,)) @ w_o

    o_lat = sweep_query_blocks(lambda a, b: attend(a, b, k1, k2, v), (q1l, q2l))
    y_lat = finish(o_lat)
    y_ctx = finish(attend(q1c, q2c, k1c, k2c, vc)) if with_ctx_out else None
    return y_lat, y_ctx


def mla_mixer(h_lat, h_ctx, w_in, g_q, g_kv, w_uq, w_ukv, w_o, cos, sin, with_ctx_out):
    H = B_HEADS
    scale = (B_NOPE + B_ROPE) ** -0.5

    def project(h):
        Bn, T, _ = h.shape
        z = h @ w_in
        cq = rmsnorm(z[..., :B_Q_LORA], g_q)
        ckv = rmsnorm(z[..., B_Q_LORA:B_Q_LORA + B_KV_LORA], g_kv)
        k_rope = z[..., B_Q_LORA + B_KV_LORA:]
        q = (cq @ w_uq).reshape(Bn, T, H, B_NOPE + B_ROPE)
        kv = (ckv @ w_ukv).reshape(Bn, T, H, B_NOPE + B_VDIM)
        return q[..., :B_NOPE], q[..., B_NOPE:], kv[..., :B_NOPE], k_rope, kv[..., B_NOPE:]

    qn_l, qr_l, kn_l, kr_l, v_l = project(h_lat)
    qr_l = apply_rope(qr_l, cos, sin)
    kr_l = apply_rope(kr_l[:, :, None, :], cos, sin)[:, :, 0]
    qn_c, qr_c, kn_c, kr_c, v_c = project(h_ctx)
    kn = jnp.concatenate([kn_c, kn_l], axis=1)
    kr = jnp.concatenate([kr_c, kr_l], axis=1)
    v = jnp.concatenate([v_c, v_l], axis=1)

    def attend(qn, qr, kn_, kr_, vv):
        s = (jnp.einsum('bqhd,bkhd->bhqk', qn, kn_) + jnp.einsum('bqhr,bkr->bhqk', qr, kr_))
        p = jax.nn.softmax(s.astype(jnp.float32) * scale, axis=-1)
        return jnp.einsum('bhqk,bkhd->bqhd', p.astype(vv.dtype), vv)

    def finish(o):
        return o.reshape(o.shape[:2] + (H * B_VDIM,)) @ w_o

    o_lat = sweep_query_blocks(lambda a, b: attend(a, b, kn, kr, v), (qn_l, qr_l))
    y_lat = finish(o_lat)
    y_ctx = finish(attend(qn_c, qr_c, kn_c, kr_c, v_c)) if with_ctx_out else None
    return y_lat, y_ctx


def neighbourhood_mixer(h_lat, h_ctx, w_qkv, rpb, w_o, rows, with_ctx_out):
    H, d = C_HEADS, C_HEAD_DIM
    scale = d ** -0.5
    kr_win = min(NA_ROWS_MAX, rows)
    kc_win = NA_COLS

    def project(h):
        Bn, T, _ = h.shape
        q, k, v = jnp.split(h @ w_qkv, 3, axis=-1)
        return q.reshape(Bn, T, H, d), k.reshape(Bn, T, H, d), v.reshape(Bn, T, H, d)

    q_l, k_l, v_l = project(h_lat)
    q_c, k_c, v_c = project(h_ctx)
    Bn, S = q_l.shape[:2]
    L = k_c.shape[1]
    q_grid = q_l.reshape(Bn, rows, GRID_W, H, d)
    k_grid = k_l.reshape(Bn, rows, GRID_W, H, d)
    v_grid = v_l.reshape(Bn, rows, GRID_W, H, d)

    qcol = np.arange(GRID_W, dtype=np.int32)
    cstart = np.clip(qcol - kc_win // 2, 0, GRID_W - kc_win)
    col_idx = (cstart[:, None] + np.arange(kc_win, dtype=np.int32)[None, :]).astype(np.int32)
    dc_idx = (col_idx - qcol[:, None] + NA_COLS - 1).astype(np.int32)
    rpb_f = rpb.astype(jnp.float32)

    def row_fn(r):
        rstart = jnp.clip(r - kr_win // 2, 0, rows - kr_win)
        q_r = lax.dynamic_index_in_dim(q_grid, r, axis=1, keepdims=False)
        k_band = lax.dynamic_slice_in_dim(k_grid, rstart, kr_win, axis=1)
        v_band = lax.dynamic_slice_in_dim(v_grid, rstart, kr_win, axis=1)
        k_win = k_band[:, :, col_idx]
        v_win = v_band[:, :, col_idx]
        dr_idx = rstart + jnp.arange(kr_win, dtype=jnp.int32) - r + NA_ROWS_MAX - 1
        bias = rpb_f[:, dr_idx[:, None, None], dc_idx[None, :, :]]
        bias = jnp.transpose(bias, (0, 2, 1, 3))
        s_lat = jnp.einsum('bqhd,brqkhd->bhqrk', q_r, k_win).astype(jnp.float32) * scale + bias[None]
        s_ctx = jnp.einsum('bqhd,bkhd->bhqk', q_r, k_c).astype(jnp.float32) * scale
        s = jnp.concatenate([s_ctx, s_lat.reshape(Bn, H, GRID_W, kr_win * kc_win)], axis=-1)
        p = jax.nn.softmax(s, axis=-1).astype(v_win.dtype)
        p_lat = p[..., L:].reshape(Bn, H, GRID_W, kr_win, kc_win)
        return (jnp.einsum('bhqk,bkhd->bqhd', p[..., :L], v_c)
                + jnp.einsum('bhqrk,brqkhd->bqhd', p_lat, v_win))

    o = lax.map(row_fn, jnp.arange(rows, dtype=jnp.int32))
    o_lat = jnp.transpose(o, (1, 0, 2, 3, 4)).reshape(Bn, S, H * d)
    y_lat = o_lat @ w_o
    y_ctx = None
    if with_ctx_out:
        s = jnp.einsum('bqhd,bkhd->bhqk', q_c, k_c).astype(jnp.float32) * scale
        p = jax.nn.softmax(s, axis=-1).astype(v_c.dtype)
        o_c = jnp.einsum('bhqk,bkhd->bqhd', p, v_c)
        y_ctx = o_c.reshape(o_c.shape[:2] + (H * d,)) @ w_o
    return y_lat, y_ctx


def setup_inputs(seed: int = 0) -> dict:
    key = jax.random.key(seed)
    keys = iter(jax.random.split(key, 64))

    def nrm(shape, scale):
        return jax.random.normal(next(keys), shape, jnp.float32) * scale

    def gain(shape):
        return 1.0 + nrm(shape, 0.05)

    D = D_MODEL
    inp = {}
    inp['x'] = nrm((BATCH, SEQ, D), 1.0)
    inp['c'] = nrm((BATCH, D), 1.0)
    inp['ctx'] = nrm((BATCH, CTX_LEN, D), 1.0)
    inp['c_ctx'] = nrm((D,), 1.0)
    for i in range(DEPTH):
        p = 'l%d_' % i
        inp[p + 'w_mod'] = nrm((D, 6 * D), D ** -0.5)
        inp[p + 'b_mod'] = nrm((6 * D,), 0.02)
        inp[p + 'g_norm'] = gain((4, D))
        inp[p + 'w_gu'] = nrm((D, 2 * FFN_HIDDEN), D ** -0.5)
        inp[p + 'w_down'] = nrm((FFN_HIDDEN, D), FFN_HIDDEN ** -0.5)
        kind = i % N_MIXERS
        if kind == 0:
            wa = 2 * A_HEADS * A_HEAD_DIM
            inp[p + 'a_w_qkv'] = nrm((D, 3 * wa), D ** -0.5)
            inp[p + 'a_w_o'] = nrm((wa, D), wa ** -0.5)
            inp[p + 'a_lam'] = nrm((4, A_HEAD_DIM), 0.1)
            inp[p + 'a_g_sub'] = gain((2 * A_HEAD_DIM,))
        elif kind == 1:
            inp[p + 'b_w_in'] = nrm((D, B_Q_LORA + B_KV_LORA + B_ROPE), D ** -0.5)
            inp[p + 'b_g_q'] = gain((B_Q_LORA,))
            inp[p + 'b_g_kv'] = gain((B_KV_LORA,))
            inp[p + 'b_w_uq'] = nrm((B_Q_LORA, B_HEADS * (B_NOPE + B_ROPE)), B_Q_LORA ** -0.5)
            inp[p + 'b_w_ukv'] = nrm((B_KV_LORA, B_HEADS * (B_NOPE + B_VDIM)), B_KV_LORA ** -0.5)
            inp[p + 'b_w_o'] = nrm((B_HEADS * B_VDIM, D), (B_HEADS * B_VDIM) ** -0.5)
        else:
            wc = C_HEADS * C_HEAD_DIM
            inp[p + 'c_w_qkv'] = nrm((D, 3 * wc), D ** -0.5)
            inp[p + 'c_rpb'] = nrm((C_HEADS, 2 * NA_ROWS_MAX - 1, 2 * NA_COLS - 1), 0.5)
            inp[p + 'c_w_o'] = nrm((wc, D), wc ** -0.5)
    return inp


def reference(x, c, ctx, c_ctx,
              l0_w_mod, l0_b_mod, l0_g_norm, l0_w_gu, l0_w_down,
              l0_a_w_qkv, l0_a_w_o, l0_a_lam, l0_a_g_sub,
              l1_w_mod, l1_b_mod, l1_g_norm, l1_w_gu, l1_w_down,
              l1_b_w_in, l1_b_g_q, l1_b_g_kv, l1_b_w_uq, l1_b_w_ukv, l1_b_w_o,
              l2_w_mod, l2_b_mod, l2_g_norm, l2_w_gu, l2_w_down,
              l2_c_w_qkv, l2_c_rpb, l2_c_w_o,
              l3_w_mod, l3_b_mod, l3_g_norm, l3_w_gu, l3_w_down,
              l3_a_w_qkv, l3_a_w_o, l3_a_lam, l3_a_g_sub):
    S = x.shape[1]
    rows = S // GRID_W
    common = [
        (l0_w_mod, l0_b_mod, l0_g_norm, l0_w_gu, l0_w_down),
        (l1_w_mod, l1_b_mod, l1_g_norm, l1_w_gu, l1_w_down),
        (l2_w_mod, l2_b_mod, l2_g_norm, l2_w_gu, l2_w_down),
        (l3_w_mod, l3_b_mod, l3_g_norm, l3_w_gu, l3_w_down),
    ]
    mixer_params = [
        (l0_a_w_qkv, l0_a_w_o, l0_a_lam, l0_a_g_sub),
        (l1_b_w_in, l1_b_g_q, l1_b_g_kv, l1_b_w_uq, l1_b_w_ukv, l1_b_w_o),
        (l2_c_w_qkv, l2_c_rpb, l2_c_w_o),
        (l3_a_w_qkv, l3_a_w_o, l3_a_lam, l3_a_g_sub),
    ]
    cos_a, sin_a = axial_rope_tables(S, A_HEAD_DIM)
    cos_b, sin_b = axial_rope_tables(S, B_ROPE)

    for i in range(DEPTH):
        w_mod, b_mod, g_norm, w_gu, w_down = common[i]
        last = i == DEPTH - 1
        m_lat = (jax.nn.silu(c) @ w_mod + b_mod)[:, None, :]
        m_ctx = jax.nn.silu(c_ctx) @ w_mod + b_mod
        sh1, sc1, g1, sh2, sc2, g2 = jnp.split(m_lat, 6, axis=-1)
        csh1, csc1, cg1, csh2, csc2, cg2 = jnp.split(m_ctx, 6, axis=-1)

        h_lat = rmsnorm(x, g_norm[0]) * (1.0 + sc1) + sh1
        h_ctx = rmsnorm(ctx, g_norm[0]) * (1.0 + csc1) + csh1
        kind = i % N_MIXERS
        if kind == 0:
            y_lat, y_ctx = diff_attention_mixer(h_lat, h_ctx, *mixer_params[i], lambda_init(i),
                                                cos_a, sin_a, not last)
        elif kind == 1:
            y_lat, y_ctx = mla_mixer(h_lat, h_ctx, *mixer_params[i], cos_b, sin_b, not last)
        else:
            y_lat, y_ctx = neighbourhood_mixer(h_lat, h_ctx, *mixer_params[i], rows, not last)

        x = x + g1 * rmsnorm(y_lat, g_norm[1])
        f_lat = swiglu(rmsnorm(x, g_norm[2]) * (1.0 + sc2) + sh2, w_gu, w_down)
        x = x + g2 * rmsnorm(f_lat, g_norm[3])

        if not last:
            ctx = ctx + cg1 * rmsnorm(y_ctx, g_norm[1])
            f_ctx = swiglu(rmsnorm(ctx, g_norm[2]) * (1.0 + csc2) + csh2, w_gu, w_down)
            ctx = ctx + cg2 * rmsnorm(f_ctx, g_norm[3])
    return x
```

```cpp
#include <hip/hip_runtime.h>
#include <hip/hip_cooperative_groups.h>
#include <cstdio>
#include <cstdint>
namespace cg = cooperative_groups;

#define LAS __attribute__((address_space(3)))
#define GAS __attribute__((address_space(1)))
typedef unsigned short bf16_t;
typedef short bf16x8 __attribute__((ext_vector_type(8)));
typedef float f32x2 __attribute__((ext_vector_type(2)));
typedef float f32x4 __attribute__((ext_vector_type(4)));
typedef float f32x16 __attribute__((ext_vector_type(16)));
typedef unsigned u32x2 __attribute__((ext_vector_type(2)));
typedef unsigned u32x4 __attribute__((ext_vector_type(4)));
typedef __bf16 bf2_t __attribute__((ext_vector_type(2)));

#define DI __device__ __forceinline__
DI unsigned pk2(float lo, float hi) { f32x2 v = {lo, hi}; return __builtin_bit_cast(unsigned, __builtin_convertvector(v, bf2_t)); }
DI float bflo(unsigned u) { return __builtin_bit_cast(float, u << 16); }
DI float bfhi(unsigned u) { return __builtin_bit_cast(float, u & 0xffff0000u); }
DI u32x4 pack8(f32x4 a, f32x4 b) { u32x4 w; w.x = pk2(a[0], a[1]); w.y = pk2(a[2], a[3]); w.z = pk2(b[0], b[1]); w.w = pk2(b[2], b[3]); return w; }
DI float wave_sum(float v) {
#pragma unroll
    for (int o = 1; o < 64; o <<= 1) v += __shfl_xor(v, o);
    return v;
}

constexpr int D = 1024, NB = 4, SEQ = 8192, CTX = 256, TPB = SEQ + CTX, MTOT = NB * TPB, FF = 2816, NMOD = 6 * D;
constexpr float EPS = 1e-6f;
constexpr float LOG2E = 1.4426950408889634f;

constexpr size_t MiB = 1u << 20;
constexpr size_t WS_MOD = 1 * MiB, WS_MODP = 2 * MiB, WS_ROPEA = 10 * MiB, WS_ROPEB = 12 * MiB, WS_XCTX = 13 * MiB, WS_W = 17 * MiB, WS_H = 115 * MiB, WS_R = 181 * MiB, WS_END = 511 * MiB;
constexpr size_t WL = 12845056;
constexpr size_t W_GU = 0, W_DN = 5767168, W_MX = 8650752, W_WO = W_MX + 3145728;
constexpr size_t W_WIN = W_MX, W_WUQ = W_MX + 786432, W_WUKV = W_WUQ + 393216;

namespace pg8 {
constexpr int BM = 256, BK = 64, HALF = 128, HTB = HALF * BK * 2, STAGE_BYTES = 8 * HTB, NXCD = 8, WGM = 8;
__host__ __device__ __forceinline__ int lds_byte(int r, int c) { const int st = (r >> 4) * 2 + (c >> 5), rr = r & 15, cc = c & 31, ob = rr * 64 + cc * 2; return st * 1024 + (ob ^ (((ob >> 9) & 1) << 5)); }
__host__ __device__ __forceinline__ void stage_rc(int b, int& R, int& C) { const int st = b / 1024, sb = b % 1024, swz = sb ^ (((sb >> 9) & 1) << 5); R = (st >> 1) * 16 + swz / 64; C = (st & 1) * 32 + (swz % 64) / 2; }
__host__ __device__ __forceinline__ int perm32(int rho) { const int n = rho >> 4, i = rho & 15; return 8 * (i >> 2) + 4 * n + (i & 3); }
struct Unit { int pm, pn; };
struct Gemm { const bf16_t* A; const bf16_t* Bt; int K; };
struct StaticOrder {
    int nM, nN, nwg, G, c, skip;
    __host__ __device__ void init(int M, int N, int G_, int c_, int skip_) { nM = M / BM; nN = N / BM; nwg = nM * nN; G = G_; c = c_; skip = skip_; }
    __host__ __device__ bool next(int i, Unit& u) const {
        const long L = (long)i * G + c; if (L >= nwg) return false;
        int wgid = (int)L; { const int q = nwg / NXCD, r = nwg % NXCD, xcd = wgid % NXCD, off = wgid / NXCD; wgid = (xcd < r ? xcd * (q + 1) : r * (q + 1) + (xcd - r) * q) + off; }
        const int nig = WGM * nN, gid = wgid / nig, fm = gid * WGM, gsz = (nM - fm) < WGM ? (nM - fm) : WGM;
        u.pm = fm + ((wgid % nig) % gsz); u.pn = (wgid % nig) / gsz; if (skip) u.pm += (u.pm >> 5) + 1; return true;
    }
};
template <class Epi, class Sched>
__device__ __forceinline__ void gemm_phase(LAS unsigned char* lds, const Gemm g, const Sched& S, const Epi& E, const int tid) {
    const int wid = __builtin_amdgcn_readfirstlane(tid >> 6), lane = tid & 63, wr = wid >> 2, wc = wid & 3, fr = lane & 15, fq = lane >> 4;
    const int K = g.K, nt = K / BK;
    unsigned voffA[2], voffB[2];
#pragma unroll
    for (int i = 0; i < 2; ++i) { int R, C; stage_rc(tid * 16 + i * 8192, R, C); const int Rb = (R & ~31) + perm32(R & 31);
        voffA[i] = (unsigned)(R * K + C) * 2u; voffB[i] = (unsigned)(Rb * K + C) * 2u; }
    const size_t kstep = (size_t)(BK * 2);
    const size_t hstep = (size_t)HALF * K * 2, tstep = 2 * hstep;
    const unsigned ldsw = (unsigned)wid * 1024u;
    const int aoff = lds_byte(wr * 64 + fr, fq * 8), boff = lds_byte(wc * 32 + fr, fq * 8);
#define PG8_SA(b, h) (((b) * 2 + (h)) * HTB)
#define PG8_SB(b, h) ((4 + (b) * 2 + (h)) * HTB)
#define PG8_STAGE(bufoff, gbase, voff) do { _Pragma("unroll") for (int _i = 0; _i < 2; ++_i) \
        __builtin_amdgcn_global_load_lds((const unsigned*)((const char*)(gbase) + (voff)[_i]), (LAS unsigned*)(lds + (bufoff) + ldsw + _i * 8192), 16, 0, 0); } while (0)
#define PG8_LDA(dst, b, h) do { _Pragma("unroll") for (int m = 0; m < 4; ++m) _Pragma("unroll") for (int k = 0; k < 2; ++k) dst[m][k] = *(const LAS bf16x8*)(lds + PG8_SA(b, h) + aoff + m * 2048 + k * 1024); } while (0)
#define PG8_LDB(dst, b, h) do { _Pragma("unroll") for (int n = 0; n < 2; ++n) _Pragma("unroll") for (int k = 0; k < 2; ++k) dst[n][k] = *(const LAS bf16x8*)(lds + PG8_SB(b, h) + boff + n * 2048 + k * 1024); } while (0)
#define PG8_MMA(ai, bj, At, Bt) do { __builtin_amdgcn_s_setprio(1); _Pragma("unroll") for (int m = 0; m < 4; ++m) _Pragma("unroll") for (int n = 0; n < 2; ++n) _Pragma("unroll") for (int k = 0; k < 2; ++k) \
        acc[ai][bj][m][n] = __builtin_amdgcn_mfma_f32_16x16x32_bf16(Bt[n][k], At[m][k], acc[ai][bj][m][n], 0, 0, 0); __builtin_amdgcn_s_setprio(0); } while (0)
#define PG8_WAIT_V(n) asm volatile("s_waitcnt vmcnt(" #n ")" ::: "memory")
#define PG8_WAIT_L(n) asm volatile("s_waitcnt lgkmcnt(" #n ")" ::: "memory")
#define PG8_BAR __builtin_amdgcn_s_barrier()
#define PG8_SCHED __builtin_amdgcn_sched_barrier(0)
    Unit cur, nxt; int ui = 0;
    if (!S.next(0, cur)) return;
    f32x4 acc[2][2][4][2];
#pragma unroll
    for (int a = 0; a < 2; ++a)
#pragma unroll
        for (int b = 0; b < 2; ++b)
#pragma unroll
            for (int m = 0; m < 4; ++m)
#pragma unroll
                for (int n = 0; n < 2; ++n) acc[a][b][m][n] = (f32x4){0.f, 0.f, 0.f, 0.f};
    bf16x8 At[4][2], B0[2][2], B1[2][2];
    const char* cA = (const char*)g.A + (size_t)cur.pm * tstep; const char* cB = (const char*)g.Bt + (size_t)cur.pn * tstep;
    PG8_STAGE(PG8_SB(0, 0), cB, voffB); PG8_STAGE(PG8_SB(0, 1), cB + hstep, voffB); PG8_STAGE(PG8_SA(0, 0), cA, voffA); PG8_STAGE(PG8_SA(0, 1), cA + hstep, voffA);
    if (wr == 1) PG8_BAR;
    PG8_WAIT_V(2); PG8_BAR;
    PG8_STAGE(PG8_SB(1, 0), cB + kstep, voffB); PG8_STAGE(PG8_SA(1, 0), cA + kstep, voffA); PG8_STAGE(PG8_SB(1, 1), cB + hstep + kstep, voffB);
    PG8_WAIT_V(6); PG8_BAR;
    for (;;) {
        const bool has_next = S.next(ui + 1, nxt);
        const char* nA = has_next ? (const char*)g.A + (size_t)nxt.pm * tstep : cA; const char* nB = has_next ? (const char*)g.Bt + (size_t)nxt.pn * tstep : cB;
        for (int t = 0; t < nt; t += 2) {
            const bool last = (t == nt - 2);
            const char* a1 = cA + (size_t)(t + 1) * kstep;
            const char* a2 = last ? nA : cA + (size_t)(t + 2) * kstep; const char* b2 = last ? nB : cB + (size_t)(t + 2) * kstep;
            const char* a3 = a2 + kstep; const char* b3 = b2 + kstep;
            PG8_LDB(B0, 0, 0); PG8_LDB(B1, 0, 1); PG8_SCHED; PG8_LDA(At, 0, 0); PG8_STAGE(PG8_SA(1, 1), a1 + hstep, voffA);
            PG8_WAIT_V(8); PG8_WAIT_L(0); PG8_BAR; PG8_MMA(0, 0, At, B0); PG8_MMA(0, 1, At, B1); PG8_BAR; PG8_SCHED;
            PG8_LDA(At, 0, 1); PG8_STAGE(PG8_SB(0, 0), b2, voffB); PG8_STAGE(PG8_SB(0, 1), b2 + hstep, voffB); PG8_STAGE(PG8_SA(0, 0), a2, voffA);
            PG8_WAIT_V(8); PG8_WAIT_L(0); PG8_BAR; PG8_MMA(1, 0, At, B0); PG8_MMA(1, 1, At, B1); PG8_BAR; PG8_SCHED;
            PG8_LDB(B0, 1, 0); PG8_LDB(B1, 1, 1); PG8_SCHED; PG8_LDA(At, 1, 0); PG8_STAGE(PG8_SA(0, 1), a2 + hstep, voffA);
            PG8_WAIT_V(8); PG8_WAIT_L(0); PG8_BAR; PG8_MMA(0, 0, At, B0); PG8_MMA(0, 1, At, B1); PG8_BAR; PG8_SCHED;
            PG8_LDA(At, 1, 1); PG8_STAGE(PG8_SB(1, 0), b3, voffB); PG8_STAGE(PG8_SB(1, 1), b3 + hstep, voffB); PG8_STAGE(PG8_SA(1, 0), a3, voffA);
            PG8_WAIT_V(8); PG8_WAIT_L(0); PG8_BAR; PG8_MMA(1, 0, At, B0); PG8_MMA(1, 1, At, B1); PG8_BAR; PG8_SCHED;
        }
        if (wr == 0) PG8_BAR;
        E(acc, cur, wr, wc, fr, fq);
        if (!has_next) break;
#pragma unroll
        for (int a = 0; a < 2; ++a)
#pragma unroll
            for (int b = 0; b < 2; ++b)
#pragma unroll
                for (int m = 0; m < 4; ++m)
#pragma unroll
                    for (int n = 0; n < 2; ++n) acc[a][b][m][n] = (f32x4){0.f, 0.f, 0.f, 0.f};
        cur = nxt; cA = nA; cB = nB; ++ui;
        if (wr == 1) PG8_BAR;
    }
    PG8_WAIT_V(0);
    PG8_BAR;
#undef PG8_SA
#undef PG8_SB
#undef PG8_STAGE
#undef PG8_LDA
#undef PG8_LDB
#undef PG8_MMA
#undef PG8_WAIT_V
#undef PG8_WAIT_L
#undef PG8_BAR
#undef PG8_SCHED
}
}

typedef f32x4 AccT[2][2][4][2];

struct EpiStore {
    bf16_t* O; int ldc;
    DI void operator()(const AccT& acc, const pg8::Unit& u, int wr, int wc, int fr, int fq) const {
        const int row0 = u.pm * 256 + wr * 64 + fr, col0 = u.pn * 256 + wc * 32 + 8 * fq;
#pragma unroll
        for (int ai = 0; ai < 2; ++ai)
#pragma unroll
            for (int m = 0; m < 4; ++m) { bf16_t* rowp = O + (size_t)(row0 + ai * 128 + m * 16) * ldc + col0;
#pragma unroll
                for (int bj = 0; bj < 2; ++bj) *(GAS u32x4*)(rowp + bj * 128) = pack8(acc[ai][bj][m][0], acc[ai][bj][m][1]); }
    }
};
struct EpiSwiGLU {
    bf16_t* O;
    DI void operator()(const AccT& acc, const pg8::Unit& u, int wr, int wc, int fr, int fq) const {
        const int row0 = u.pm * 256 + wr * 64 + fr, col0 = u.pn * 128 + wc * 32 + 8 * fq;
#pragma unroll
        for (int ai = 0; ai < 2; ++ai)
#pragma unroll
            for (int m = 0; m < 4; ++m) {
                f32x4 r[2];
#pragma unroll
                for (int n = 0; n < 2; ++n)
#pragma unroll
                    for (int j = 0; j < 4; ++j) { const float gv = acc[ai][0][m][n][j], uv = acc[ai][1][m][n][j];
                        r[n][j] = gv * __builtin_amdgcn_rcpf(1.f + __builtin_amdgcn_exp2f(-gv * LOG2E)) * uv; }
                *(GAS u32x4*)(O + (size_t)(row0 + ai * 128 + m * 16) * FF + col0) = pack8(r[0], r[1]);
            }
    }
};
struct EpiQK {
    bf16_t* Q; long long kdelta; const f32x2* rope; int mode; float qscale;
    DI void operator()(const AccT& acc, const pg8::Unit& u, int wr, int wc, int fr, int fq) const {
        const int rt0 = u.pm * 256, b = rt0 / TPB, pt0 = rt0 - b * TPB, pbase = pt0 + wr * 64 + fr;
        const bool lat = pt0 >= CTX;
        const int pn = u.pn;
        const bool roped = (mode == 0) || (mode == 1 && pn >= 4);
        const int dqk = (mode == 1 || mode == 2) ? 96 : 64;
        const bool toK = (mode == 2) || ((mode == 0 || mode == 3) && pn >= 4);
        bf16_t* dst = Q + (toK ? kdelta : 0ll);
        const float qs = toK ? 1.f : qscale;
        if (!roped) {
#pragma unroll
            for (int bj = 0; bj < 2; ++bj) {
                const int head = 4 * (pn & 3) + 2 * bj + (wc >> 1), d0 = 32 * (wc & 1) + 8 * fq;
                bf16_t* hp = dst + ((size_t)(b * 16 + head) * TPB + pbase) * dqk + d0;
#pragma unroll
                for (int ai = 0; ai < 2; ++ai)
#pragma unroll
                    for (int m = 0; m < 4; ++m) *(GAS u32x4*)(hp + (size_t)(ai * 128 + m * 16) * dqk) = pack8(acc[ai][bj][m][0] * qs, acc[ai][bj][m][1] * qs);
            }
        } else {
            int head, i0, half, doff, rtw;
            if (mode == 0) { head = (pn & 3) * 4 + wc; i0 = 8 * fq; half = 32; doff = 0; rtw = 32; }
            else { head = 8 * (pn - 4) + 2 * wc + (fq >> 1); i0 = 8 * (fq & 1); half = 16; doff = 64; rtw = 16; }
            bf16_t* hp = dst + ((size_t)(b * 16 + head) * TPB + pbase) * dqk + doff + i0;
#pragma unroll
            for (int ai = 0; ai < 2; ++ai)
#pragma unroll
                for (int m = 0; m < 4; ++m) {
                    const int dp = ai * 128 + m * 16;
                    f32x4 a0 = acc[ai][0][m][0], a1 = acc[ai][0][m][1], b0 = acc[ai][1][m][0], b1 = acc[ai][1][m][1];
                    f32x4 o10, o11, o20, o21;
                    if (lat) {
                        const GAS f32x4* cs = (const GAS f32x4*)(rope + (size_t)(pbase + dp - CTX) * rtw + i0);
                        const f32x4 c01 = cs[0], c23 = cs[1], c45 = cs[2], c67 = cs[3];
                        o10[0] = a0[0] * c01[0] - b0[0] * c01[1]; o20[0] = a0[0] * c01[1] + b0[0] * c01[0];
                        o10[1] = a0[1] * c01[2] - b0[1] * c01[3]; o20[1] = a0[1] * c01[3] + b0[1] * c01[2];
                        o10[2] = a0[2] * c23[0] - b0[2] * c23[1]; o20[2] = a0[2] * c23[1] + b0[2] * c23[0];
                        o10[3] = a0[3] * c23[2] - b0[3] * c23[3]; o20[3] = a0[3] * c23[3] + b0[3] * c23[2];
                        o11[0] = a1[0] * c45[0] - b1[0] * c45[1]; o21[0] = a1[0] * c45[1] + b1[0] * c45[0];
                        o11[1] = a1[1] * c45[2] - b1[1] * c45[3]; o21[1] = a1[1] * c45[3] + b1[1] * c45[2];
                        o11[2] = a1[2] * c67[0] - b1[2] * c67[1]; o21[2] = a1[2] * c67[1] + b1[2] * c67[0];
                        o11[3] = a1[3] * c67[2] - b1[3] * c67[3]; o21[3] = a1[3] * c67[3] + b1[3] * c67[2];
                    } else { o10 = a0; o11 = a1; o20 = b0; o21 = b1; }
                    *(GAS u32x4*)(hp + (size_t)dp * dqk) = pack8(o10 * qs, o11 * qs);
                    *(GAS u32x4*)(hp + (size_t)dp * dqk + half) = pack8(o20 * qs, o21 * qs);
                }
        }
    }
};

constexpr int NUNITS = NB * 16 * 33;
template <int DQK, int DV, int NAT, int VSHIFT, int COMB>
__device__ __forceinline__ void attn_phase(LAS unsigned char* lds, const bf16_t* Q, const bf16_t* K, const bf16_t* Vt, bf16_t* O, int ldo, float scale, const float* rpb, int vcu, int G, const int tid,
                                           bf16_t* Hout, const float* gsub, float lam, float oml) {
    constexpr bool DMA = true;
    constexpr bool K128 = DMA && !NAT;
    constexpr int KS = DMA ? (DQK == 64 ? 128 : 256) : DQK * 2 + 16,
         VS = DMA ? 128 : 144, KBYTES = 64 * KS, VBYTES = DV * VS, NSL = K128 ? 4 : 2;
    constexpr int KCH = 8 * DQK, KPT = (KCH + 511) / 512, VCH = DV * 8, VPT = VCH / 512, CPR = DQK / 8;
    constexpr int VOFF = NSL * KBYTES, RPBOFF = NSL * KBYTES + NSL * VBYTES;
    constexpr bool QREG = true;
    constexpr int QOFF = RPBOFF + (NAT ? 2048 : 0), QW = (DQK / 16) * 1024;
    constexpr int NQ = 2 * (DQK / 16), NP2 = 2 * (DV / 32), VPM1 = (48 + NQ - 1) / NQ, VPM2 = (48 + NP2 - 1) / NP2;
    const int lane = tid & 63, w = __builtin_amdgcn_readfirstlane(tid >> 6), n = lane & 31, hh = lane >> 5;
    const int pim = (n & 0x13) | ((n & 4) << 1) | ((n & 8) >> 1);
    LAS float* rpb_s = (LAS float*)(lds + RPBOFF);
    const int swk = (KS == 128) ? ((pim >> 1) & 7) : (pim & 15), swv = (n >> 1) & 7;
#define ATT_KOFF(c) (DMA ? ((((c) ^ swk)) << 4) : ((c) << 4))
#define ATT_VOFFS(c) (DMA ? ((((c) ^ swv)) << 4) : ((c) << 4))
    constexpr int DKPT = KS / 128;
    unsigned dko[DKPT], dvo[DV / 64];
    { const int r_ = w * 8 + (lane >> 3);
#pragma unroll
      for (int i_ = 0; i_ < DKPT; ++i_) { const int cpr = KS / 16, rk = i_ * (8192 / KS) + w * (1024 / KS) + lane / cpr, cp = lane % cpr, sw = (KS == 128) ? ((rk >> 1) & 7) : (rk & 15);
          dko[i_] = (unsigned)(rk * DQK * 2 + (cp ^ sw) * 16); if ((cp ^ sw) * 8 >= DQK) dko[i_] = 0xffffffffu; }
#pragma unroll
      for (int i_ = 0; i_ < DV / 64; ++i_) { const int rv = i_ * 64 + r_; dvo[i_] = (unsigned)(rv * MTOT + ((lane & 7) ^ ((rv >> 1) & 7)) * 8) * 2u; } }
    unsigned lvo[VPT];
#pragma unroll
    for (int p = 0; p < VPT; ++p) { const int c = tid + 512 * p; lvo[p] = (unsigned)(((c >> 3) * MTOT + (c & 7) * 8) * 2); }
    (void)scale;
    constexpr int NU = COMB ? NB * 8 * 33 : NUNITS, NBIG = COMB ? 1024 : 2048;
    for (int ui = vcu; ui < NU; ui += G) {
        int bx_, qb;
        if (ui < NBIG) { bx_ = ui >> 5; qb = 1 + (ui & 31); } else { bx_ = ui - NBIG; qb = 0; }
#pragma unroll 1
      for (int s2 = 0; s2 < (COMB ? 2 : 1); ++s2) {
        const int bv = COMB ? ((bx_ >> 3) * 16 + (bx_ & 7) * 2 + s2) : bx_;
        const int b = bv >> 4, vh = bv & 15, hv = vh >> VSHIFT;
        const bf16_t* Kb = K + (size_t)bv * TPB * DQK;
        const bf16_t* Vb = Vt + (size_t)hv * DV * MTOT + (size_t)b * TPB;
        int nkt, lo = 0;
        if (qb == 0) nkt = 4;
        else if (!NAT) nkt = TPB / 64;
        else { const int r0 = (qb - 1) * 4; lo = min(max(r0 - 4, 0), 120); const int hi = min(max(r0 - 1, 0), 120) + 8; nkt = 4 + hi - lo; }
        const int pos_q = qb * 256 + w * 32 + n;
        const int qr = (qb - 1) * 4 + (w >> 1), qrs = min(max(qr - 4, 0), 120);
        int lq_ = lane; asm volatile("" : "+v"(lq_));
        const bf16_t* qp = Q + ((size_t)bv * TPB + qb * 256 + w * 32 + (lq_ & 31)) * DQK + (lq_ >> 5) * 8;
        bf16x8 qg[DQK / 16];
#pragma unroll
        for (int ks = 0; ks < DQK / 16; ++ks) qg[ks] = *(const GAS bf16x8*)(qp + ks * 16);
        LAS unsigned char* qs = lds + QOFF + w * QW + lane * 16;
        f32x16 o[DV / 32];
#pragma unroll
        for (int dt = 0; dt < DV / 32; ++dt)
#pragma unroll
            for (int i = 0; i < 16; ++i) o[dt][i] = 0.f;
        float l_run = 0.f;
        f32x16 negm;
#pragma unroll
        for (int i = 0; i < 16; ++i) negm[i] = 0.f;
        u32x4 kr[KPT], vr[VPT];
#define ATT_KEY0(kt) ((!NAT || (kt) < 4) ? (kt) * 64 : CTX + (lo + (kt) - 4) * 64)
#define ATT_ACTIVE(kt) (!(NAT && (kt) >= 4) || ((lo + (kt) - 4 >= qrs) && (lo + (kt) - 4 < qrs + 8)))
#define ATT_LOADK(kt) do { const int k0_ = ATT_KEY0(kt); \
        _Pragma("unroll") for (int p = 0; p < KPT; ++p) { const int c = tid + 512 * p; if (c < KCH) kr[p] = *(const GAS u32x4*)((const GAS char*)(Kb + (size_t)k0_ * DQK) + (unsigned)(c * 16)); } } while (0)
#define ATT_LOADV(kt) do { const int k0_ = ATT_KEY0(kt); \
        _Pragma("unroll") for (int p = 0; p < VPT; ++p) vr[p] = *(const GAS u32x4*)((const GAS char*)(Vb + k0_) + lvo[p]); } while (0)
#define ATT_STOREK(buf) do { \
        _Pragma("unroll") for (int p = 0; p < KPT; ++p) { const int c = tid + 512 * p; if (c < KCH) *(LAS u32x4*)(lds + (buf) * KBYTES + (c / CPR) * KS + (c % CPR) * 16) = kr[p]; } } while (0)
#define ATT_STOREV(buf) do { \
        _Pragma("unroll") for (int p = 0; p < VPT; ++p) { const int c = tid + 512 * p; *(LAS u32x4*)(lds + VOFF + (buf) * VBYTES + (c >> 3) * VS + (c & 7) * 16) = vr[p]; } } while (0)
#define ATT_DMAK(kt, slot) do { const int k0_ = ATT_KEY0(kt); \
        _Pragma("unroll") for (int i_ = 0; i_ < DKPT; ++i_) { \
            if (DQK == 64 || dko[i_] != 0xffffffffu) \
                __builtin_amdgcn_global_load_lds((const unsigned*)((const char*)(Kb + (size_t)k0_ * DQK) + dko[i_]), (LAS unsigned*)(lds + (slot) * KBYTES + i_ * 8192 + w * 1024), 16, 0, 0); } } while (0)
#define ATT_DMAV(kt, slot) do { const int k0_ = ATT_KEY0(kt); \
        _Pragma("unroll") for (int i_ = 0; i_ < DV / 64; ++i_) \
            __builtin_amdgcn_global_load_lds((const unsigned*)((const char*)(Vb + k0_) + dvo[i_]), (LAS unsigned*)(lds + VOFF + (slot) * VBYTES + i_ * 8192 + w * 1024), 16, 0, 0); } while (0)
#define ATT_QK(sa, sb, buf) do { LAS const unsigned char* kb_ = lds + (buf) * KBYTES; \
        bf16x8 ka_[DQK / 16], kc_[DQK / 16], qf[DQK / 16]; \
        _Pragma("unroll") for (int ks = 0; ks < DQK / 16; ++ks) { \
            qf[ks] = QREG ? qg[ks] : *(LAS const bf16x8*)(qs + ks * 1024); \
            ka_[ks] = *(LAS const bf16x8*)(kb_ + pim * KS + ATT_KOFF(2 * ks + hh)); \
            kc_[ks] = *(LAS const bf16x8*)(kb_ + (32 + pim) * KS + ATT_KOFF(2 * ks + hh)); } \
        __builtin_amdgcn_sched_barrier(0); \
        sa = __builtin_amdgcn_mfma_f32_32x32x16_bf16(ka_[0], qf[0], negm, 0, 0, 0); \
        sb = __builtin_amdgcn_mfma_f32_32x32x16_bf16(kc_[0], qf[0], negm, 0, 0, 0); \
        _Pragma("unroll") for (int ks = 1; ks < DQK / 16; ++ks) { \
            sa = __builtin_amdgcn_mfma_f32_32x32x16_bf16(ka_[ks], qf[ks], sa, 0, 0, 0); \
            sb = __builtin_amdgcn_mfma_f32_32x32x16_bf16(kc_[ks], qf[ks], sb, 0, 0, 0); } \
        __builtin_amdgcn_sched_barrier(0); } while (0)
#define ATT_MASK(s0, s1, kt) do { \
        const int krow = lo + (kt) - 4; const bool rin = (krow >= qrs) && (krow < qrs + 8); \
        const int cq = (w & 1) * 32 + n, cst = min(max(cq - 8, 0), 48); \
        LAS const float* bp = rpb_s + (rin ? (krow - qr + 7) : 0) * 31 - cq + 15; \
        _Pragma("unroll") for (int i = 0; i < 16; ++i) { \
            const int kc0 = 16 * (i >> 3) + 8 * hh + (i & 7), kc1 = kc0 + 32; \
            const bool v0 = rin && (kc0 >= cst) && (kc0 < cst + 16), v1 = rin && (kc1 >= cst) && (kc1 < cst + 16); \
            const float b0 = v0 ? bp[kc0] : 0.f, b1 = v1 ? bp[kc1] : 0.f; \
            s0[i] = v0 ? (s0[i] + b0 * LOG2E) : -1e30f; \
            s1[i] = v1 ? (s1[i] + b1 * LOG2E) : -1e30f; } } while (0)
#define ATT_SOFT_FAST(sv, pa, pb, lsum) do { float l0_ = 0.f; \
        _Pragma("unroll") for (int i = 0; i < 4; ++i) { \
            const float e0 = __builtin_amdgcn_exp2f(sv[2 * i]), e1 = __builtin_amdgcn_exp2f(sv[2 * i + 1]), e2 = __builtin_amdgcn_exp2f(sv[8 + 2 * i]), e3 = __builtin_amdgcn_exp2f(sv[9 + 2 * i]); \
            l0_ += e0; l0_ += e1; l0_ += e2; l0_ += e3; pa[i] = pk2(e0, e1); pb[i] = pk2(e2, e3); } \
        lsum = l0_; } while (0)
#define ATT_SOFT_SLOW(sv, pa, pb, lsum, first, ADJ) do { \
        float d_ = fmaxf(fmaxf(sv[0], sv[1]), fmaxf(sv[2], sv[3])); \
        _Pragma("unroll") for (int i = 4; i < 16; i += 2) d_ = fmaxf(d_, fmaxf(sv[i], sv[i + 1])); \
        d_ = fmaxf(d_, __shfl_xor(d_, 32)); \
        const float delta = (first) ? d_ : fmaxf(d_, 0.f); \
        if (!(first)) { const float alpha = __builtin_amdgcn_exp2f(-delta); l_run *= alpha; \
            _Pragma("unroll") for (int dt = 0; dt < DV / 32; ++dt) _Pragma("unroll") for (int i = 0; i < 16; ++i) o[dt][i] *= alpha; } \
        _Pragma("unroll") for (int i = 0; i < 16; ++i) { sv[i] -= delta; ADJ; negm[i] -= delta; } \
        float l2 = 0.f; \
        _Pragma("unroll") for (int i = 0; i < 4; ++i) { \
            const float e0 = __builtin_amdgcn_exp2f(sv[2 * i]), e1 = __builtin_amdgcn_exp2f(sv[2 * i + 1]), e2 = __builtin_amdgcn_exp2f(sv[8 + 2 * i]), e3 = __builtin_amdgcn_exp2f(sv[9 + 2 * i]); \
            l2 += (e0 + e1) + (e2 + e3); pa[i] = pk2(e0, e1); pb[i] = pk2(e2, e3); } \
        lsum = l2; } while (0)
#define ATT_PIN(v_) do { asm volatile("" : "+v"(v_.x)); asm volatile("" : "+v"(v_.y)); asm volatile("" : "+v"(v_.z)); asm volatile("" : "+v"(v_.w)); } while (0)
#define ATT_STEP(sc0, sc1, sn0, sn1, kt, PAR) do { \
        if (K128) { if ((PAR) == 0) { if ((kt) + 3 < nkt) ATT_DMAK((kt) + 3, ((kt) + 3) & 3); if ((kt) + 4 < nkt) ATT_DMAK((kt) + 4, (kt) & 3); \
                                       if ((kt) + 2 < nkt) ATT_DMAV((kt) + 2, ((kt) + 2) & 3); if ((kt) + 3 < nkt) ATT_DMAV((kt) + 3, ((kt) + 3) & 3); } } \
        else if (DMA) { if ((kt) + 2 < nkt) ATT_DMAK((kt) + 2, (kt) & 1); if ((kt) + 1 < nkt) ATT_DMAV((kt) + 1, ((kt) + 1) & 1); } \
        else { if ((kt) + 2 < nkt) ATT_LOADK((kt) + 2); if ((kt) + 1 < nkt) ATT_LOADV((kt) + 1); } \
        if (NAT && (kt) >= 4) ATT_MASK(sc0, sc1, kt); \
        u32x4 pq0, pq1, pq2, pq3; float lsA, lsB; \
        { LAS const unsigned char* kb_ = lds + (((kt) + 1) & (NSL - 1)) * KBYTES; \
          bf16x8 ka_[DQK / 16], kc_[DQK / 16], qf[DQK / 16]; \
          _Pragma("unroll") for (int ks = 0; ks < DQK / 16; ++ks) { \
              qf[ks] = QREG ? qg[ks] : *(LAS const bf16x8*)(qs + ks * 1024); \
              ka_[ks] = *(LAS const bf16x8*)(kb_ + pim * KS + ATT_KOFF(2 * ks + hh)); \
              kc_[ks] = *(LAS const bf16x8*)(kb_ + (32 + pim) * KS + ATT_KOFF(2 * ks + hh)); } \
          sn0 = __builtin_amdgcn_mfma_f32_32x32x16_bf16(ka_[0], qf[0], negm, 0, 0, 0); \
          sn1 = __builtin_amdgcn_mfma_f32_32x32x16_bf16(kc_[0], qf[0], negm, 0, 0, 0); \
          _Pragma("unroll") for (int ks = 1; ks < DQK / 16; ++ks) { \
              sn0 = __builtin_amdgcn_mfma_f32_32x32x16_bf16(ka_[ks], qf[ks], sn0, 0, 0, 0); \
              sn1 = __builtin_amdgcn_mfma_f32_32x32x16_bf16(kc_[ks], qf[ks], sn1, 0, 0, 0); } \
          ATT_SOFT_FAST(sc0, pq0, pq1, lsA); if (DV == 64) { ATT_PIN(pq0); ATT_PIN(pq1); }     \
          __builtin_amdgcn_sched_group_barrier(0x100, QREG ? 4 : 6, 0); \
          _Pragma("unroll") for (int ks = 0; ks < DQK / 16; ++ks) { \
              __builtin_amdgcn_sched_group_barrier(0x008, 1, 0); __builtin_amdgcn_sched_group_barrier(0x002, VPM1, 0); \
              __builtin_amdgcn_sched_group_barrier(0x008, 1, 0); __builtin_amdgcn_sched_group_barrier(0x002, VPM1, 0); \
              if (ks + 2 < DQK / 16) __builtin_amdgcn_sched_group_barrier(0x100, QREG ? 2 : 3, 0); } \
          __builtin_amdgcn_sched_barrier(0); } \
        if (__builtin_amdgcn_ballot_w64(((kt) == 0) || !(lsA < 1e18f)) != 0ull) ATT_SOFT_SLOW(sc0, pq0, pq1, lsA, (kt) == 0, sc1[i] -= delta; sn0[i] -= delta; sn1[i] -= delta); \
        l_run += lsA; \
        LAS const unsigned char* vb_ = lds + VOFF + ((kt) & (NSL - 1)) * VBYTES; \
        { const bf16x8 pf0 = __builtin_bit_cast(bf16x8, pq0), pf1 = __builtin_bit_cast(bf16x8, pq1); \
          bf16x8 vf_[DV / 32][2]; \
          _Pragma("unroll") for (int dt = 0; dt < DV / 32; ++dt) _Pragma("unroll") for (int kk = 0; kk < 2; ++kk) \
              vf_[dt][kk] = *(LAS const bf16x8*)(vb_ + (dt * 32 + n) * VS + ATT_VOFFS(2 * kk + hh)); \
          _Pragma("unroll") for (int dt = 0; dt < DV / 32; ++dt) { \
              o[dt] = __builtin_amdgcn_mfma_f32_32x32x16_bf16(vf_[dt][0], pf0, o[dt], 0, 0, 0); \
              o[dt] = __builtin_amdgcn_mfma_f32_32x32x16_bf16(vf_[dt][1], pf1, o[dt], 0, 0, 0); } \
          ATT_SOFT_FAST(sc1, pq2, pq3, lsB); if (DV == 64) { ATT_PIN(pq2); ATT_PIN(pq3); } \
          __builtin_amdgcn_sched_group_barrier(0x100, NP2, 0); \
          _Pragma("unroll") for (int i = 0; i < NP2; ++i) { __builtin_amdgcn_sched_group_barrier(0x008, 1, 0); __builtin_amdgcn_sched_group_barrier(0x002, VPM2, 0); } \
          __builtin_amdgcn_sched_barrier(0); } \
        if (__builtin_amdgcn_ballot_w64(!(lsB < 1e18f)) != 0ull) ATT_SOFT_SLOW(sc1, pq2, pq3, lsB, false, sn0[i] -= delta; sn1[i] -= delta); \
        l_run += lsB; \
        { const bf16x8 pf2 = __builtin_bit_cast(bf16x8, pq2), pf3 = __builtin_bit_cast(bf16x8, pq3); \
          bf16x8 vf_[DV / 32][2]; \
          _Pragma("unroll") for (int dt = 0; dt < DV / 32; ++dt) _Pragma("unroll") for (int kk = 0; kk < 2; ++kk) \
              vf_[dt][kk] = *(LAS const bf16x8*)(vb_ + (dt * 32 + n) * VS + ATT_VOFFS(2 * (kk + 2) + hh)); \
          __builtin_amdgcn_sched_barrier(0); __builtin_amdgcn_s_setprio(1); \
          _Pragma("unroll") for (int dt = 0; dt < DV / 32; ++dt) { \
              o[dt] = __builtin_amdgcn_mfma_f32_32x32x16_bf16(vf_[dt][0], pf2, o[dt], 0, 0, 0); \
              o[dt] = __builtin_amdgcn_mfma_f32_32x32x16_bf16(vf_[dt][1], pf3, o[dt], 0, 0, 0); } \
          __builtin_amdgcn_s_setprio(0); __builtin_amdgcn_sched_barrier(0); } \
        if (K128) { if ((PAR) == 1) { asm volatile("s_waitcnt vmcnt(0)" ::: "memory"); __syncthreads(); } } \
        else if (DMA) { asm volatile("s_waitcnt vmcnt(0)" ::: "memory"); __syncthreads(); } \
        else { if ((kt) + 2 < nkt) ATT_STOREK((kt) & 1); if ((kt) + 1 < nkt) ATT_STOREV(((kt) + 1) & 1); __syncthreads(); } } while (0)
        __syncthreads();
        if (NAT) { for (int i = tid; i < 465; i += 512) rpb_s[i] = rpb[vh * 465 + i]; }
#pragma unroll
        for (int ks = 0; ks < DQK / 16; ++ks) { if (!QREG) *(LAS bf16x8*)(qs + ks * 1024) = qg[ks]; }
        if (K128) { ATT_DMAK(0, 0); ATT_DMAV(0, 0); ATT_DMAK(1, 1); ATT_DMAV(1, 1); ATT_DMAK(2, 2); asm volatile("s_waitcnt vmcnt(0)" ::: "memory"); }
        else if (DMA) { ATT_DMAK(0, 0); ATT_DMAV(0, 0); ATT_DMAK(1, 1); asm volatile("s_waitcnt vmcnt(0)" ::: "memory"); }
        else { ATT_LOADK(0); ATT_STOREK(0); ATT_LOADV(0); ATT_STOREV(0); ATT_LOADK(1); ATT_STOREK(1); }
        __syncthreads();
        f32x16 sA0, sA1, sB0, sB1;
        ATT_QK(sA0, sA1, 0);
        __syncthreads();
        for (int kt = 0; kt < nkt; kt += 2) {
            ATT_STEP(sA0, sA1, sB0, sB1, kt, 0);
            if (kt + 1 < nkt) ATT_STEP(sB0, sB1, sA0, sA1, kt + 1, 1);
        }
        const float lt = l_run + __shfl_xor(l_run, 32), inv = 1.f / lt;
        int lf_ = lane; asm volatile("" : "+v"(lf_));
        const int nf_ = lf_ & 31, hf_ = lf_ >> 5, posf_ = qb * 256 + w * 32 + nf_;
#define ATT_SWAP(a_, b_) do { const u32x2 r_ = __builtin_amdgcn_permlane32_swap((a_), (b_), false, false); (a_) = r_[0]; (b_) = r_[1]; } while (0)
        bf16_t* op = O + (size_t)(b * TPB + posf_) * ldo + vh * DV + 8 * hf_;
        if (COMB && s2 == 1) {
            const bf16_t* o1p = op - DV;
            float ss = 0.f;
#pragma unroll
            for (int dt = 0; dt < DV / 32; ++dt)
#pragma unroll
                for (int j = 0; j < 2; ++j) {
                    u32x4 r1 = *(const GAS u32x4*)(o1p + dt * 32 + 16 * j);
                    ATT_SWAP(r1.x, r1.z); ATT_SWAP(r1.y, r1.w);
#pragma unroll
                    for (int q = 0; q < 2; ++q) { const int g4 = 2 * j + q; const unsigned lo_ = q ? r1.z : r1.x, hi_ = q ? r1.w : r1.y;
                        const float d0 = bflo(lo_) - lam * (o[dt][4 * g4] * inv), d1 = bfhi(lo_) - lam * (o[dt][4 * g4 + 1] * inv);
                        const float d2 = bflo(hi_) - lam * (o[dt][4 * g4 + 2] * inv), d3 = bfhi(hi_) - lam * (o[dt][4 * g4 + 3] * inv);
                        o[dt][4 * g4] = d0; o[dt][4 * g4 + 1] = d1; o[dt][4 * g4 + 2] = d2; o[dt][4 * g4 + 3] = d3;
                        ss += (d0 * d0 + d1 * d1) + (d2 * d2 + d3 * d3); }
                }
            ss += __shfl_xor(ss, 32);
            const float rs = rsqrtf(ss * (1.f / 128.f) + EPS) * oml;
            bf16_t* hp = Hout + (size_t)(b * TPB + posf_) * D + (vh >> 1) * DV + 8 * hf_;
#pragma unroll
            for (int dt = 0; dt < DV / 32; ++dt)
#pragma unroll
                for (int j = 0; j < 2; ++j) {
                    const f32x4 ga = *(const GAS f32x4*)((const GAS char*)gsub + (unsigned)((dt * 32 + 16 * j + 4 * hf_) * 4)), gb = *(const GAS f32x4*)((const GAS char*)gsub + (unsigned)((dt * 32 + 16 * j + 8 + 4 * hf_) * 4));
                    u32x4 wv;
                    wv.x = pk2(o[dt][8 * j] * rs * ga[0], o[dt][8 * j + 1] * rs * ga[1]); wv.y = pk2(o[dt][8 * j + 2] * rs * ga[2], o[dt][8 * j + 3] * rs * ga[3]);
                    wv.z = pk2(o[dt][8 * j + 4] * rs * gb[0], o[dt][8 * j + 5] * rs * gb[1]); wv.w = pk2(o[dt][8 * j + 6] * rs * gb[2], o[dt][8 * j + 7] * rs * gb[3]);
                    ATT_SWAP(wv.x, wv.z); ATT_SWAP(wv.y, wv.w);
                    *(GAS u32x4*)(hp + dt * 32 + 16 * j) = wv;
                }
        } else {
#pragma unroll
            for (int dt = 0; dt < DV / 32; ++dt)
#pragma unroll
                for (int j = 0; j < 2; ++j) {
                    u32x4 wv;
                    wv.x = pk2(o[dt][8 * j] * inv, o[dt][8 * j + 1] * inv); wv.y = pk2(o[dt][8 * j + 2] * inv, o[dt][8 * j + 3] * inv);
                    wv.z = pk2(o[dt][8 * j + 4] * inv, o[dt][8 * j + 5] * inv); wv.w = pk2(o[dt][8 * j + 6] * inv, o[dt][8 * j + 7] * inv);
                    ATT_SWAP(wv.x, wv.z); ATT_SWAP(wv.y, wv.w);
                    *(GAS u32x4*)(op + dt * 32 + 16 * j) = wv;
                }
        }
#undef ATT_SWAP
#undef ATT_KEY0
#undef ATT_ACTIVE
#undef ATT_LOADK
#undef ATT_LOADV
#undef ATT_STOREK
#undef ATT_STOREV
#undef ATT_QK
#undef ATT_DMAK
#undef ATT_DMAV
#undef ATT_MASK
#undef ATT_SOFT_FAST
#undef ATT_SOFT_SLOW
#undef ATT_STEP
      }
    }
}


#define XB_TMO      128
#define XB_XCNT(j)  (256  + 64 * (j))
#define XB_XSUB(j)  (1280 + 64 * (j))
#define XB_XGEN(j)  (2304 + 64 * (j))
#define XB_TOP      3328
#define XB_TOPGEN   3392
#define XCD_BAR_WORDS 3456
#define XB_SPIN_CAP (1u << 18)
DI unsigned xb_ld(unsigned* p)              { return __hip_atomic_load(p, __ATOMIC_RELAXED, __HIP_MEMORY_SCOPE_AGENT); }
DI unsigned xb_add(unsigned* p, unsigned v) { return __hip_atomic_fetch_add(p, v, __ATOMIC_RELAXED, __HIP_MEMORY_SCOPE_AGENT); }
DI unsigned xb_xcc_id() { return (unsigned)__builtin_amdgcn_s_getreg((3 << 11) | 20) & 0xFu; }
#define XB_SPIN(cond, bar) do { unsigned _sp = 0; while (cond) { __builtin_amdgcn_s_sleep(1); \
    if ((++_sp & 255u) == 0u) { if (xb_ld(&(bar)[XB_TMO])) break; if (_sp > XB_SPIN_CAP) { atomicAdd(&(bar)[XB_TMO], 1u); break; } } } } while (0)
struct XcdBarrier { unsigned* bar; unsigned x; volatile LAS unsigned* st; };
DI void xcd_barrier_complete(unsigned* bar, unsigned x, unsigned& nloc, unsigned& nx) {
    const unsigned G = gridDim.x * gridDim.y * gridDim.z;
    unsigned sum, cnt, mine, sp = 0u;
    for (;;) {
        sum = 0u; cnt = 0u; mine = 0u;
#pragma unroll
        for (unsigned j = 0; j < 16; ++j) { const unsigned c = xb_ld(&bar[XB_XCNT(j)]); sum += c; cnt += (c > 0u) ? 1u : 0u; mine = (j == x) ? c : mine; }
        if (sum == G) break;
        __builtin_amdgcn_s_sleep(1);
        if ((++sp & 255u) == 0u) { if (xb_ld(&bar[XB_TMO])) break; if (sp > XB_SPIN_CAP) { atomicAdd(&bar[XB_TMO], 1u); break; } }
    }
    nloc = mine > 0u ? mine : 1u; nx = cnt > 0u ? cnt : 1u;
}
DI void xcd_barrier(const XcdBarrier& b) {
    asm volatile("s_waitcnt vmcnt(0)" ::: "memory");
    __syncthreads();
    if (threadIdx.x == 0) {
        unsigned* bar = b.bar;
        __builtin_amdgcn_s_waitcnt(0);
        unsigned nloc = b.st[0], nx = b.st[1];
        if (nloc == 0u) { xcd_barrier_complete(bar, b.x, nloc, nx); b.st[0] = nloc; b.st[1] = nx; }
        const unsigned old = xb_add(&bar[XB_XSUB(b.x)], 1u);
        const unsigned gen = old / nloc;
        if (old + 1u == (gen + 1u) * nloc) {
            __builtin_amdgcn_fence(__ATOMIC_RELEASE, "agent");
            asm volatile("s_waitcnt vmcnt(0)" ::: "memory");
            const unsigned og = xb_add(&bar[XB_TOP], 1u);
            const unsigned tg = og / nx;
            if (og + 1u == (tg + 1u) * nx) xb_add(&bar[XB_TOPGEN], 1u);
            else XB_SPIN(xb_ld(&bar[XB_TOPGEN]) == tg, bar);
            __builtin_amdgcn_fence(__ATOMIC_ACQUIRE, "agent");
            xb_add(&bar[XB_XGEN(b.x)], 1u);
            asm volatile("s_waitcnt vmcnt(0)" ::: "memory");
        } else {
            XB_SPIN(xb_ld(&bar[XB_XGEN(b.x)]) == gen, bar);
            __builtin_amdgcn_fence(__ATOMIC_ACQUIRE, "agent");
            asm volatile("s_waitcnt vmcnt(0)" ::: "memory");
        }
    }
    __syncthreads();
}
#define GRID_BAR() do { XcdBarrier xb_; xb_.bar = (unsigned*)p.ws; xb_.x = xb_xcc_id(); xb_.st = (volatile LAS unsigned*)(lds + 131072); xcd_barrier(xb_); } while (0)

struct MatDesc { const float* src; long long dst_off; int K, N, mode, nitems; };
constexpr int NMD = 18;
struct Params { const float* in[41]; float* out; unsigned char* ws; MatDesc md[NMD]; int nmd; int pad; };

__host__ __device__ __forceinline__ int dst_row(int mode, int n) {
    if (mode == 1) {
        if (n >= 2048) return n;
        const int tile = n >> 8, w = n & 255, gq = w >> 6, half = (w >> 5) & 1, i = w & 31; return tile * 256 + half * 128 + gq * 32 + i;
    }
    if (mode == 2) { if (n < FF) return (n >> 7) * 256 + (n & 127); const int m = n - FF; return (m >> 7) * 256 + 128 + (m & 127); }
    if (mode == 3) {
        const int h = n / 96, d = n - h * 96; if (d < 64) return h * 64 + d;
        const int i = d - 64, half = i >> 4, ii = i & 15; return 1024 + (h >> 3) * 256 + half * 128 + (h & 7) * 16 + ii;
    }
    if (mode == 4) { const int h = n >> 7, d = n & 127; return d < 64 ? h * 64 + d : 1024 + h * 64 + (d - 64); }
    return n;
}

DI void transpose_item(const float* W, int K, int N, bf16_t* WT, int mode, LAS float* scr, int item, int lane) {
    const int nblk = N / 32, kb = item / nblk, nb = item - kb * nblk, k0 = 64 * kb, n0 = 32 * nb;
#pragma unroll 8
    for (int i = 0; i < 32; ++i) { const int kk = 2 * i + (lane >> 5); scr[kk * 33 + (lane & 31)] = W[(size_t)(k0 + kk) * N + n0 + (lane & 31)]; }
    asm volatile("s_waitcnt lgkmcnt(0)" ::: "memory");
    const int c = lane & 7;
#pragma unroll
    for (int j = 0; j < 4; ++j) { const int nn = (lane >> 3) + 8 * j; const LAS float* s = scr + (8 * c) * 33 + nn;
        u32x4 o; o.x = pk2(s[0 * 33], s[1 * 33]); o.y = pk2(s[2 * 33], s[3 * 33]); o.z = pk2(s[4 * 33], s[5 * 33]); o.w = pk2(s[6 * 33], s[7 * 33]);
        *(GAS u32x4*)(WT + (size_t)dst_row(mode, n0 + nn) * K + k0 + 8 * c) = o; }
    asm volatile("s_waitcnt lgkmcnt(0)" ::: "memory");
}

DI void row_pass2(int lane, const float* xin, float* X, const bf16_t* Y, const float* gny, const float* gate, bf16_t* H, const float* gnh, const float* sc, const float* sh) {
    f32x4 v[2][4];
#pragma unroll
    for (int r = 0; r < 2; ++r)
#pragma unroll
        for (int j = 0; j < 4; ++j) v[r][j] = ((const GAS f32x4*)(xin + r * D))[64 * j + lane];
    if (Y) {
        u32x2 raw[2][4]; f32x4 gv[4], ga[4];
#pragma unroll
        for (int r = 0; r < 2; ++r)
#pragma unroll
            for (int j = 0; j < 4; ++j) raw[r][j] = ((const GAS u32x2*)(Y + r * D))[64 * j + lane];
#pragma unroll
        for (int j = 0; j < 4; ++j) { gv[j] = ((const GAS f32x4*)gny)[64 * j + lane]; ga[j] = ((const GAS f32x4*)gate)[64 * j + lane]; }
        f32x4 y[2][4]; float ss0 = 0.f, ss1 = 0.f;
#pragma unroll
        for (int j = 0; j < 4; ++j) {
            y[0][j] = (f32x4){bflo(raw[0][j].x), bfhi(raw[0][j].x), bflo(raw[0][j].y), bfhi(raw[0][j].y)};
            y[1][j] = (f32x4){bflo(raw[1][j].x), bfhi(raw[1][j].x), bflo(raw[1][j].y), bfhi(raw[1][j].y)};
            ss0 += (y[0][j][0] * y[0][j][0] + y[0][j][1] * y[0][j][1]) + (y[0][j][2] * y[0][j][2] + y[0][j][3] * y[0][j][3]);
            ss1 += (y[1][j][0] * y[1][j][0] + y[1][j][1] * y[1][j][1]) + (y[1][j][2] * y[1][j][2] + y[1][j][3] * y[1][j][3]); }
#pragma unroll
        for (int o = 1; o < 64; o <<= 1) { ss0 += __shfl_xor(ss0, o); ss1 += __shfl_xor(ss1, o); }
        const float rs0 = rsqrtf(ss0 * (1.f / D) + EPS), rs1 = rsqrtf(ss1 * (1.f / D) + EPS);
#pragma unroll
        for (int j = 0; j < 4; ++j) { const f32x4 gg = ga[j] * gv[j]; v[0][j] += gg * (y[0][j] * rs0); v[1][j] += gg * (y[1][j] * rs1); }
    }
    if (X) {
#pragma unroll
        for (int r = 0; r < 2; ++r)
#pragma unroll
            for (int j = 0; j < 4; ++j) ((GAS f32x4*)(X + r * D))[64 * j + lane] = v[r][j];
    }
    if (H) {
        f32x4 gv[4], sv[4], tv[4];
#pragma unroll
        for (int j = 0; j < 4; ++j) { gv[j] = ((const GAS f32x4*)gnh)[64 * j + lane]; sv[j] = ((const GAS f32x4*)sc)[64 * j + lane]; tv[j] = ((const GAS f32x4*)sh)[64 * j + lane]; }
        float ss0 = 0.f, ss1 = 0.f;
#pragma unroll
        for (int j = 0; j < 4; ++j) {
            ss0 += (v[0][j][0] * v[0][j][0] + v[0][j][1] * v[0][j][1]) + (v[0][j][2] * v[0][j][2] + v[0][j][3] * v[0][j][3]);
            ss1 += (v[1][j][0] * v[1][j][0] + v[1][j][1] * v[1][j][1]) + (v[1][j][2] * v[1][j][2] + v[1][j][3] * v[1][j][3]); }
#pragma unroll
        for (int o = 1; o < 64; o <<= 1) { ss0 += __shfl_xor(ss0, o); ss1 += __shfl_xor(ss1, o); }
        const float rs0 = rsqrtf(ss0 * (1.f / D) + EPS), rs1 = rsqrtf(ss1 * (1.f / D) + EPS);
#pragma unroll
        for (int j = 0; j < 4; ++j) {
            const f32x4 h0 = (v[0][j] * rs0 * gv[j]) * (1.f + sv[j]) + tv[j], h1 = (v[1][j] * rs1 * gv[j]) * (1.f + sv[j]) + tv[j];
            u32x2 w0, w1; w0.x = pk2(h0[0], h0[1]); w0.y = pk2(h0[2], h0[3]); w1.x = pk2(h1[0], h1[1]); w1.y = pk2(h1[2], h1[3]);
            ((GAS u32x2*)H)[64 * j + lane] = w0; ((GAS u32x2*)(H + D))[64 * j + lane] = w1; }
    }
}

struct GemmJob { const bf16_t* A; const bf16_t* Bt; int K, M, N, epi, crot, skip; bf16_t* o0; bf16_t* o1; int ldc, mode; const f32x2* rope; };

__global__ void __launch_bounds__(512) fwd_kernel(Params p) {
    extern __shared__ __attribute__((aligned(16))) unsigned char lds_raw[];
    LAS unsigned char* lds = (LAS unsigned char*)lds_raw;
    cg::grid_group grid = cg::this_grid();
    const int tid = threadIdx.x, lane = tid & 63, wave = __builtin_amdgcn_readfirstlane(tid >> 6);
    const int G = gridDim.x, bx = blockIdx.x;
    const int vcu = (G % 8 == 0) ? (bx % 8) * (G / 8) + bx / 8 : bx;
    const int gw = vcu * 8 + wave, NGW = G * 8;
    unsigned char* ws = p.ws;
    float* MOD = (float*)(ws + WS_MOD); float* MODP = (float*)(ws + WS_MODP);
    f32x2* ROPEA = (f32x2*)(ws + WS_ROPEA); f32x2* ROPEB = (f32x2*)(ws + WS_ROPEB);
    float* XCTX = (float*)(ws + WS_XCTX); bf16_t* WB = (bf16_t*)(ws + WS_W); bf16_t* HB = (bf16_t*)(ws + WS_H);
    unsigned char* R = ws + WS_R;
    float* OUT = p.out;

    if (bx == 0) { for (int i = tid; i < XCD_BAR_WORDS; i += 512) ((unsigned*)ws)[i] = 0u; }
    if (tid < 4) ((LAS unsigned*)(lds + 131072))[tid] = 0u;
    __syncthreads();
    {
        LAS float* sl = (LAS float*)lds;
        for (int T0 = bx * 512; T0 < 4 * 16 * 1536; T0 += G * 512) {
            const int lkc = T0 / 1536, l = lkc >> 4, kc = lkc & 15, n4 = (T0 - lkc * 1536) + tid;
            __syncthreads();
            if (tid < 320) { const int v = tid >> 6, k = tid & 63; const float cv = (v < 4) ? p.in[1][v * D + kc * 64 + k] : p.in[3][kc * 64 + k]; sl[tid] = cv / (1.f + __expf(-cv)); }
            __syncthreads();
            const float* wm = p.in[4 + (l == 0 ? 0 : (l == 1 ? 9 : (l == 2 ? 20 : 28)))] + (size_t)(kc * 64) * NMOD + n4 * 4;
            f32x4 a0 = {0, 0, 0, 0}, a1 = a0, a2 = a0, a3 = a0, a4 = a0;
#pragma unroll 4
            for (int k = 0; k < 64; ++k) { const f32x4 wv = *(const GAS f32x4*)(wm + (size_t)k * NMOD);
                a0 += sl[k] * wv; a1 += sl[64 + k] * wv; a2 += sl[128 + k] * wv; a3 += sl[192 + k] * wv; a4 += sl[256 + k] * wv; }
            float* mp = MODP + (size_t)(lkc * 5) * NMOD + n4 * 4;
            *(GAS f32x4*)(mp) = a0; *(GAS f32x4*)(mp + NMOD) = a1; *(GAS f32x4*)(mp + 2 * NMOD) = a2; *(GAS f32x4*)(mp + 3 * NMOD) = a3; *(GAS f32x4*)(mp + 4 * NMOD) = a4;
        }
        __syncthreads();
        LAS float* scr = (LAS float*)(lds + wave * 16384);
        int total = 0;
        for (int i = 0; i < p.nmd; ++i) total += p.md[i].nitems;
        for (int it = gw; it < total; it += NGW) {
            int r = it, di = 0;
            while (r >= p.md[di].nitems) { r -= p.md[di].nitems; ++di; }
            transpose_item(p.md[di].src, p.md[di].K, p.md[di].N, WB + p.md[di].dst_off, p.md[di].mode, scr, r, lane);
        }
        { GAS u32x4* z = (GAS u32x4*)(WB + 1 * WL + W_WIN + (size_t)544 * D); const int nz = 224 * D / 8; const u32x4 zz = {0u, 0u, 0u, 0u};
          for (int i = bx * 512 + tid; i < nz; i += G * 512) z[i] = zz; }
        const float l2t = 13.287712379549449f;
        for (int i = bx * 512 + tid; i < SEQ * 32; i += G * 512) { const int t = i >> 5, j = i & 31; const float pv = (j < 16) ? (float)(t >> 6) : (float)(t & 63);
            const float inv = exp2f(-(float)(j & 15) * (1.f / 16.f) * l2t), ang = pv * inv; ROPEA[i] = (f32x2){cosf(ang), sinf(ang)}; }
        for (int i = bx * 512 + tid; i < SEQ * 16; i += G * 512) { const int t = i >> 4, j = i & 15; const float pv = (j < 8) ? (float)(t >> 6) : (float)(t & 63);
            const float inv = exp2f(-(float)(j & 7) * (1.f / 8.f) * l2t), ang = pv * inv; ROPEB[i] = (f32x2){cosf(ang), sinf(ang)}; }
    }
    grid.sync();
    if (tid == 0) (void)xb_add(&((unsigned*)ws)[XB_XCNT(xb_xcc_id())], 1u);
    for (int i = bx * 512 + tid; i < 4 * 5 * NMOD; i += G * 512) {
        const int l = i / (5 * NMOD), rem = i - l * 5 * NMOD, v = rem / NMOD, nn = rem - v * NMOD;
        float s = p.in[5 + (l == 0 ? 0 : (l == 1 ? 9 : (l == 2 ? 20 : 28)))][nn];
#pragma unroll
        for (int kc = 0; kc < 16; ++kc) s += MODP[(size_t)((l * 16 + kc) * 5 + v) * NMOD + nn];
        MOD[i] = s;
    }
    GRID_BAR();
    for (int pr = gw; pr < MTOT / 2; pr += NGW) {
        const int row = 2 * pr;
        const int b = row / TPB, pos = row - b * TPB; const bool isc = pos < CTX;
        const float* src = isc ? p.in[2] + (size_t)(b * CTX + pos) * D : p.in[0] + (size_t)(b * SEQ + pos - CTX) * D;
        float* X = isc ? XCTX + (size_t)(b * CTX + pos) * D : OUT + (size_t)(b * SEQ + pos - CTX) * D;
        const float* md = MOD + (size_t)(isc ? 4 : b) * NMOD;
        row_pass2(lane, src, X, nullptr, nullptr, nullptr, HB + (size_t)row * D, p.in[6], md + D, md);
    }
    GRID_BAR();

#define PHASE_PTRS \
            int sq_ = st; asm volatile("" : "+s"(sq_)); \
            const int l = sq_ / 10, ph = sq_ - l * 10, kind = l % 3; \
            const int ib = (l == 0 ? 4 : (l == 1 ? 13 : (l == 2 ? 24 : 32))); \
            int ln = (int)__builtin_amdgcn_mbcnt_hi(~0u, __builtin_amdgcn_mbcnt_lo(~0u, 0u)); asm volatile("" : "+v"(ln)); int td = wave * 64 + ln; \
            unsigned char* wsl = p.ws; asm volatile("" : "+s"(wsl)); \
            float* MOD = (float*)(wsl + WS_MOD); f32x2* ROPEA = (f32x2*)(wsl + WS_ROPEA); f32x2* ROPEB = (f32x2*)(wsl + WS_ROPEB); \
            float* XCTX = (float*)(wsl + WS_XCTX); bf16_t* HB = (bf16_t*)(wsl + WS_H); \
            unsigned char* R = wsl + WS_R; float* OUT = p.out; \
            const float* gnorm = p.in[ib + 2]; \
            bf16_t* WLp = (bf16_t*)(wsl + WS_W) + (size_t)l * WL; \
            bf16_t* Qb = (bf16_t*)R; \
            bf16_t* Kb = (bf16_t*)(R + (kind == 1 ? 99 : 66) * MiB); \
            bf16_t* Vtb = (bf16_t*)(R + (kind == 1 ? 198 : 132) * MiB); \
            bf16_t* Ob = (bf16_t*)(R + (kind == 1 ? 264 : 198) * MiB); \
            bf16_t* Zb = (bf16_t*)(R + 264 * MiB); \
            bf16_t* CQ = HB; bf16_t* CKV = HB + (size_t)MTOT * 256; \
            bf16_t* Yb = (bf16_t*)R; bf16_t* ACT = (bf16_t*)R; \
            (void)MOD; (void)ROPEA; (void)ROPEB; (void)XCTX; (void)OUT; (void)gnorm; (void)WLp; (void)Qb; (void)Kb; (void)Vtb; (void)Ob; (void)Zb; (void)CQ; (void)CKV; (void)Yb; (void)ACT; (void)ln; (void)td; (void)ib;
#pragma unroll 1
    for (int st = 0; st < 40; ++st) {
        bool did = false;
        {
            PHASE_PTRS
            int njobs = 0;
            if (ph == 0) njobs = (kind == 1) ? 1 : 2;
            else if (ph == 2) njobs = (kind == 1) ? 3 : 0;
            else if (ph == 5 || ph == 7 || ph == 8) njobs = 1;
            did = njobs > 0;
#pragma unroll 1
            for (int j = 0; j < njobs; ++j) {
                GemmJob gj; gj.crot = 0; gj.skip = 0; gj.o1 = nullptr; gj.rope = nullptr; gj.mode = 0; gj.ldc = D; gj.K = D; gj.M = MTOT; gj.N = D; gj.epi = 0; gj.o0 = nullptr; gj.A = HB; gj.Bt = WLp;
                if (ph == 0) {
                    if (kind == 1) { gj.Bt = WLp + W_WIN; gj.N = 768; gj.o0 = Zb; gj.ldc = 768; }
                    else if (j == 0) { gj.Bt = WLp + W_MX; gj.N = 2048; gj.epi = 1; gj.o0 = Qb; gj.o1 = Kb; gj.mode = (kind == 0) ? 0 : 3; gj.rope = ROPEA; }
                    else { gj.A = WLp + W_MX + (size_t)2048 * D; gj.Bt = HB; gj.M = D; gj.N = MTOT; gj.o0 = Vtb; gj.ldc = MTOT; gj.crot = G / 2; }
                } else if (ph == 2) {
                    gj.K = 256;
                    if (j == 0) { gj.A = CQ; gj.Bt = WLp + W_WUQ; gj.N = 1536; gj.epi = 1; gj.o0 = Qb; gj.o1 = Kb; gj.mode = 1; gj.rope = ROPEB; }
                    else if (j == 1) { gj.A = CKV; gj.Bt = WLp + W_WUKV; gj.N = 1024; gj.epi = 1; gj.o0 = Qb; gj.o1 = Kb; gj.mode = 2; gj.crot = G / 4; }
                    else { gj.A = WLp + W_WUKV + (size_t)1024 * 256; gj.Bt = CKV; gj.M = 1024; gj.N = MTOT; gj.o0 = Vtb; gj.ldc = MTOT; gj.crot = G / 2; }
                } else if (ph == 5) { gj.A = (kind == 0) ? HB : Ob; gj.Bt = WLp + W_WO; gj.o0 = Yb; }
                else if (ph == 7) { gj.Bt = WLp + W_GU; gj.N = 2 * FF; gj.epi = 2; gj.o0 = ACT; }
                else { gj.A = ACT; gj.Bt = WLp + W_DN; gj.K = FF; gj.o0 = HB; }
                if (l == 3 && ph >= 5) { gj.M = NB * SEQ; gj.skip = 1; }
                pg8::StaticOrder S; S.init(gj.M, gj.N, G, (bx + gj.crot) % G, gj.skip);
                const pg8::Gemm gg{gj.A, gj.Bt, gj.K};
                if (gj.epi == 0) { EpiStore E{gj.o0, gj.ldc}; pg8::gemm_phase<EpiStore, pg8::StaticOrder>(lds, gg, S, E, td); }
                else if (gj.epi == 1) { EpiQK E{gj.o0, (long long)(gj.o1 - gj.o0), gj.rope, gj.mode, ((gj.mode == 1) ? 0.10206207261596577f : 0.125f) * LOG2E}; pg8::gemm_phase<EpiQK, pg8::StaticOrder>(lds, gg, S, E, td); }
                else { EpiSwiGLU E{gj.o0}; pg8::gemm_phase<EpiSwiGLU, pg8::StaticOrder>(lds, gg, S, E, td); }
            }
        }
        {
            PHASE_PTRS
            if (ph == 1 && kind == 1) {
                did = true;
                const float* gq = p.in[19]; const float* gkv = p.in[20];
                for (int row = gw; row < MTOT; row += NGW) {
                    const int b = row / TPB, pos = row - b * TPB;
                    const bf16_t* z = Zb + (size_t)row * 768;
                    const u32x2 rq = ((const GAS u32x2*)z)[ln], rk = ((const GAS u32x2*)(z + 256))[ln];
                    f32x4 q4 = {bflo(rq.x), bfhi(rq.x), bflo(rq.y), bfhi(rq.y)}, k4 = {bflo(rk.x), bfhi(rk.x), bflo(rk.y), bfhi(rk.y)};
                    const float sq = wave_sum((q4[0] * q4[0] + q4[1] * q4[1]) + (q4[2] * q4[2] + q4[3] * q4[3]));
                    const float sk = wave_sum((k4[0] * k4[0] + k4[1] * k4[1]) + (k4[2] * k4[2] + k4[3] * k4[3]));
                    const float rq_ = rsqrtf(sq * (1.f / 256.f) + EPS), rk_ = rsqrtf(sk * (1.f / 256.f) + EPS);
                    const f32x4 g1 = ((const GAS f32x4*)gq)[ln], g2 = ((const GAS f32x4*)gkv)[ln];
                    q4 = q4 * rq_ * g1; k4 = k4 * rk_ * g2;
                    u32x2 wq; wq.x = pk2(q4[0], q4[1]); wq.y = pk2(q4[2], q4[3]); ((GAS u32x2*)(CQ + (size_t)row * 256))[ln] = wq;
                    u32x2 wk; wk.x = pk2(k4[0], k4[1]); wk.y = pk2(k4[2], k4[3]); ((GAS u32x2*)(CKV + (size_t)row * 256))[ln] = wk;
                    const int i = ln & 15;
                    const float t1 = bflo((unsigned)z[512 + i]), t2 = bflo((unsigned)z[528 + i]);
                    float o1 = t1, o2 = t2;
                    if (pos >= CTX) { const f32x2 cs = ROPEB[(size_t)(pos - CTX) * 16 + i]; o1 = t1 * cs[0] - t2 * cs[1]; o2 = t1 * cs[1] + t2 * cs[0]; }
                    const int part = ln & 3, head = ln >> 2;
                    float e[8];
#pragma unroll
                    for (int jj = 0; jj < 8; ++jj) { const int srcl = (8 * part + jj) & 15; const float v1 = __shfl(o1, srcl), v2 = __shfl(o2, srcl); e[jj] = (part < 2) ? v1 : v2; }
                    u32x4 wv; wv.x = pk2(e[0], e[1]); wv.y = pk2(e[2], e[3]); wv.z = pk2(e[4], e[5]); wv.w = pk2(e[6], e[7]);
                    *(GAS u32x4*)(Kb + ((size_t)(b * 16 + head) * TPB + pos) * 96 + 64 + 8 * part) = wv;
                }
            }
            if (ph == 3) {
                did = true;
                if (kind == 0) {
                    const float* lam_v = p.in[ib + 7];
                    const float lam_init = (l == 0) ? 0.2f : 0.5560582042f;
                    const float sa = wave_sum(lam_v[ln] * lam_v[64 + ln]), sb = wave_sum(lam_v[128 + ln] * lam_v[192 + ln]);
                    const float lam = expf(sa) - expf(sb) + lam_init;
                    attn_phase<64, 128, 0, 1, 1>(lds, Qb, Kb, Vtb, Ob, 2048, 0.125f, nullptr, vcu, G, td, HB, p.in[ib + 8], lam, 1.f - lam_init);
                }
                else if (kind == 1) attn_phase<96, 64, 0, 0, 0>(lds, Qb, Kb, Vtb, Ob, 1024, 0.10206207261596577f, nullptr, vcu, G, td, nullptr, nullptr, 0.f, 0.f);
                else attn_phase<64, 64, 1, 0, 0>(lds, Qb, Kb, Vtb, Ob, 1024, 0.125f, p.in[30], vcu, G, td, nullptr, nullptr, 0.f, 0.f);
            }
            if (false) {
                did = true;
                const float* lam_v = p.in[ib + 7]; const float* gsub = p.in[ib + 8];
                const float lam_init = (l == 0) ? 0.2f : 0.5560582042f;
                const float sa = wave_sum(lam_v[ln] * lam_v[64 + ln]), sb = wave_sum(lam_v[128 + ln] * lam_v[192 + ln]);
                const float lam = expf(sa) - expf(sb) + lam_init;
                const int head = ln >> 3, e0 = (ln & 7) * 16;
                float gs[16];
#pragma unroll
                for (int i = 0; i < 16; ++i) gs[i] = gsub[e0 + i] * (1.f - lam_init);
                for (int row = gw; row < MTOT; row += NGW) {
                    const bf16_t* o1p = Ob + (size_t)row * 2048 + (2 * head) * 128 + e0;
                    const u32x4 a0 = ((const GAS u32x4*)o1p)[0], a1 = ((const GAS u32x4*)o1p)[1], b0 = ((const GAS u32x4*)(o1p + 128))[0], b1 = ((const GAS u32x4*)(o1p + 128))[1];
                    float d[16];
#pragma unroll
                    for (int i = 0; i < 4; ++i) { d[2 * i] = bflo(a0[i]) - lam * bflo(b0[i]); d[2 * i + 1] = bfhi(a0[i]) - lam * bfhi(b0[i]);
                        d[8 + 2 * i] = bflo(a1[i]) - lam * bflo(b1[i]); d[8 + 2 * i + 1] = bfhi(a1[i]) - lam * bfhi(b1[i]); }
                    float ss = 0.f;
#pragma unroll
                    for (int i = 0; i < 16; ++i) ss += d[i] * d[i];
                    ss += __shfl_xor(ss, 1); ss += __shfl_xor(ss, 2); ss += __shfl_xor(ss, 4);
                    const float rs = rsqrtf(ss * (1.f / 128.f) + EPS);
                    u32x4 w0, w1;
                    w0.x = pk2(d[0] * rs * gs[0], d[1] * rs * gs[1]); w0.y = pk2(d[2] * rs * gs[2], d[3] * rs * gs[3]); w0.z = pk2(d[4] * rs * gs[4], d[5] * rs * gs[5]); w0.w = pk2(d[6] * rs * gs[6], d[7] * rs * gs[7]);
                    w1.x = pk2(d[8] * rs * gs[8], d[9] * rs * gs[9]); w1.y = pk2(d[10] * rs * gs[10], d[11] * rs * gs[11]); w1.z = pk2(d[12] * rs * gs[12], d[13] * rs * gs[13]); w1.w = pk2(d[14] * rs * gs[14], d[15] * rs * gs[15]);
                    GAS u32x4* hp = (GAS u32x4*)(HB + (size_t)row * D + head * 128 + e0); hp[0] = w0; hp[1] = w1;
                }
            }
            if (ph == 6 || ph == 9) {
                did = true;
                const bool first = (ph == 6);
                const bool has_h = first || l < 3;
                const int ibn = (l == 0 ? 13 : (l == 1 ? 24 : 32));
                for (int pr = gw; pr < MTOT / 2; pr += NGW) {
                    const int row = 2 * pr;
                    const int b = row / TPB, pos = row - b * TPB; const bool isc = pos < CTX;
                    if (l == 3 && isc) continue;
                    float* X = isc ? XCTX + (size_t)(b * CTX + pos) * D : OUT + (size_t)(b * SEQ + pos - CTX) * D;
                    const float* md = MOD + (size_t)(l * 5 + (isc ? 4 : b)) * NMOD;
                    const float* mdn = MOD + (size_t)((l + 1) * 5 + (isc ? 4 : b)) * NMOD;
                    if (first) row_pass2(ln, X, X, Yb + (size_t)row * D, gnorm + D, md + 2 * D, HB + (size_t)row * D, gnorm + 2 * D, md + 4 * D, md + 3 * D);
                    else row_pass2(ln, X, X, HB + (size_t)row * D, gnorm + 3 * D, md + 5 * D, has_h ? HB + (size_t)row * D : nullptr, has_h ? p.in[ibn + 2] : nullptr, mdn + D, mdn);
                }
            }
        }
        if (did) GRID_BAR();
    }
}

constexpr int LDS_BYTES = 132 * 1024;
extern "C" void kernel_launch(void* const* d_in, const int* in_sizes, int n_in, void* d_out, int out_size, void* d_ws, size_t ws_size, hipStream_t stream) {
    static int grid_blocks = 0;
    if (grid_blocks == 0) {
        if (n_in != 41 || ws_size < WS_END) { fprintf(stderr, "kernel_launch: unexpected n_in %d or ws %zu (need %zu)\n", n_in, ws_size, (size_t)WS_END); grid_blocks = -1; return; }
        int dev = 0, cus = 0, per_cu = 0;
        hipGetDevice(&dev);
        hipDeviceGetAttribute(&cus, hipDeviceAttributeMultiprocessorCount, dev);
        if (hipFuncSetAttribute((const void*)fwd_kernel, hipFuncAttributeMaxDynamicSharedMemorySize, LDS_BYTES) != hipSuccess) { fprintf(stderr, "kernel_launch: hipFuncSetAttribute failed\n"); }
        if (hipOccupancyMaxActiveBlocksPerMultiprocessor(&per_cu, (const void*)fwd_kernel, 512, LDS_BYTES) != hipSuccess || per_cu < 1) { fprintf(stderr, "kernel_launch: occupancy query gave %d\n", per_cu); per_cu = 1; }
        (void)hipGetLastError();
        grid_blocks = cus * 1;
    }
    if (grid_blocks < 0) return;
    Params p{};
    for (int i = 0; i < 41; ++i) p.in[i] = (const float*)d_in[i];
    p.out = (float*)d_out; p.ws = (unsigned char*)d_ws;
    int nm = 0;
    auto add = [&](int idx, long long off, int K, int N, int mode) { MatDesc& m = p.md[nm++]; m.src = (const float*)d_in[idx]; m.dst_off = off; m.K = K; m.N = N; m.mode = mode; m.nitems = (K / 64) * (N / 32); };
    const int ibs[4] = {4, 13, 24, 32};
    for (int l = 0; l < 4; ++l) {
        const long long base = (long long)l * WL; const int ib = ibs[l], kind = l % 3;
        add(ib + 3, base + W_GU, D, 2 * FF, 2);
        add(ib + 4, base + W_DN, FF, D, 0);
        if (kind == 0) { add(ib + 5, base + W_MX, D, 3 * D, 1); add(ib + 6, base + W_WO, D, D, 0); }
        else if (kind == 1) { add(ib + 5, base + W_WIN, D, 544, 0); add(ib + 8, base + W_WUQ, 256, 1536, 3); add(ib + 9, base + W_WUKV, 256, 2048, 4); add(ib + 10, base + W_WO, D, D, 0); }
        else { add(ib + 5, base + W_MX, D, 3 * D, 0); add(ib + 7, base + W_WO, D, D, 0); }
    }
    p.nmd = nm; p.pad = 0;
    void* args[] = {&p};
    hipError_t e = hipLaunchCooperativeKernel((const void*)fwd_kernel, dim3(grid_blocks), dim3(512), args, LDS_BYTES, stream);
    if (e != hipSuccess) fprintf(stderr, "cooperative launch failed: %s (grid %d)\n", hipGetErrorString(e), grid_blocks);
}
```

```cpp
#include <hip/hip_runtime.h>
#include <hip/hip_cooperative_groups.h>
#include <cstdio>
#include <cstdint>
namespace cg = cooperative_groups;

#define LAS __attribute__((address_space(3)))
#define GAS __attribute__((address_space(1)))
typedef unsigned short bf16_t;
typedef short bf16x8 __attribute__((ext_vector_type(8)));
typedef float f32x2 __attribute__((ext_vector_type(2)));
typedef float f32x4 __attribute__((ext_vector_type(4)));
typedef float f32x16 __attribute__((ext_vector_type(16)));
typedef unsigned u32x2 __attribute__((ext_vector_type(2)));
typedef unsigned u32x4 __attribute__((ext_vector_type(4)));
typedef __bf16 bf2_t __attribute__((ext_vector_type(2)));

#define DI __device__ __forceinline__
DI unsigned pk2(float lo, float hi) { f32x2 v = {lo, hi}; return __builtin_bit_cast(unsigned, __builtin_convertvector(v, bf2_t)); }
DI float bflo(unsigned u) { return __builtin_bit_cast(float, u << 16); }
DI float bfhi(unsigned u) { return __builtin_bit_cast(float, u & 0xffff0000u); }
DI u32x4 pack8(f32x4 a, f32x4 b) { u32x4 w; w.x = pk2(a[0], a[1]); w.y = pk2(a[2], a[3]); w.z = pk2(b[0], b[1]); w.w = pk2(b[2], b[3]); return w; }
DI float wave_sum(float v) {
#pragma unroll
    for (int o = 1; o < 64; o <<= 1) v += __shfl_xor(v, o);
    return v;
}

constexpr int D = 1024, NB = 4, SEQ = 8192, CTX = 256, TPB = SEQ + CTX, MTOT = NB * TPB, FF = 2816, NMOD = 6 * D;
constexpr float EPS = 1e-6f;
constexpr float LOG2E = 1.4426950408889634f;

constexpr size_t MiB = 1u << 20;
constexpr size_t WS_MOD = 1 * MiB, WS_MODP = 2 * MiB, WS_ROPEA = 10 * MiB, WS_ROPEB = 12 * MiB, WS_XCTX = 13 * MiB, WS_W = 17 * MiB, WS_H = 115 * MiB, WS_R = 181 * MiB, WS_END = 511 * MiB;
constexpr size_t WL = 12845056;
constexpr size_t W_GU = 0, W_DN = 5767168, W_MX = 8650752, W_WO = W_MX + 3145728;
constexpr size_t W_WIN = W_MX, W_WUQ = W_MX + 786432, W_WUKV = W_WUQ + 393216;

namespace pg8 {
constexpr int BM = 256, BK = 64, HALF = 128, HTB = HALF * BK * 2, STAGE_BYTES = 8 * HTB, NXCD = 8, WGM = 8;
__host__ __device__ __forceinline__ int lds_byte(int r, int c) { const int st = (r >> 4) * 2 + (c >> 5), rr = r & 15, cc = c & 31, ob = rr * 64 + cc * 2; return st * 1024 + (ob ^ (((ob >> 9) & 1) << 5)); }
__host__ __device__ __forceinline__ void stage_rc(int b, int& R, int& C) { const int st = b / 1024, sb = b % 1024, swz = sb ^ (((sb >> 9) & 1) << 5); R = (st >> 1) * 16 + swz / 64; C = (st & 1) * 32 + (swz % 64) / 2; }
__host__ __device__ __forceinline__ int perm32(int rho) { const int n = rho >> 4, i = rho & 15; return 8 * (i >> 2) + 4 * n + (i & 3); }
struct Unit { int pm, pn; };
struct Gemm { const bf16_t* A; const bf16_t* Bt; int K; };
struct StaticOrder {
    int nM, nN, nwg, G, c, skip;
    __host__ __device__ void init(int M, int N, int G_, int c_, int skip_) { nM = M / BM; nN = N / BM; nwg = nM * nN; G = G_; c = c_; skip = skip_; }
    __host__ __device__ bool next(int i, Unit& u) const {
        const long L = (long)i * G + c; if (L >= nwg) return false;
        int wgid = (int)L; { const int q = nwg / NXCD, r = nwg % NXCD, xcd = wgid % NXCD, off = wgid / NXCD; wgid = (xcd < r ? xcd * (q + 1) : r * (q + 1) + (xcd - r) * q) + off; }
        const int nig = WGM * nN, gid = wgid / nig, fm = gid * WGM, gsz = (nM - fm) < WGM ? (nM - fm) : WGM;
        u.pm = fm + ((wgid % nig) % gsz); u.pn = (wgid % nig) / gsz; if (skip) u.pm += (u.pm >> 5) + 1; return true;
    }
};
template <class Epi, class Sched>
__device__ __forceinline__ void gemm_phase(LAS unsigned char* lds, const Gemm g, const Sched& S, const Epi& E, const int tid) {
    const int wid = __builtin_amdgcn_readfirstlane(tid >> 6), lane = tid & 63, wr = wid >> 2, wc = wid & 3, fr = lane & 15, fq = lane >> 4;
    const int K = g.K, nt = K / BK;
    unsigned voffA[2], voffB[2];
#pragma unroll
    for (int i = 0; i < 2; ++i) { int R, C; stage_rc(tid * 16 + i * 8192, R, C); const int Rb = (R & ~31) + perm32(R & 31);
        voffA[i] = (unsigned)(R * K + C) * 2u; voffB[i] = (unsigned)(Rb * K + C) * 2u; }
    const size_t kstep = (size_t)(BK * 2);
    const size_t hstep = (size_t)HALF * K * 2, tstep = 2 * hstep;
    const unsigned ldsw = (unsigned)wid * 1024u;
    const int aoff = lds_byte(wr * 64 + fr, fq * 8), boff = lds_byte(wc * 32 + fr, fq * 8);
#define PG8_SA(b, h) (((b) * 2 + (h)) * HTB)
#define PG8_SB(b, h) ((4 + (b) * 2 + (h)) * HTB)
#define PG8_STAGE(bufoff, gbase, voff) do { _Pragma("unroll") for (int _i = 0; _i < 2; ++_i) \
        __builtin_amdgcn_global_load_lds((const unsigned*)((const char*)(gbase) + (voff)[_i]), (LAS unsigned*)(lds + (bufoff) + ldsw + _i * 8192), 16, 0, 0); } while (0)
#define PG8_LDA(dst, b, h) do { _Pragma("unroll") for (int m = 0; m < 4; ++m) _Pragma("unroll") for (int k = 0; k < 2; ++k) dst[m][k] = *(const LAS bf16x8*)(lds + PG8_SA(b, h) + aoff + m * 2048 + k * 1024); } while (0)
#define PG8_LDB(dst, b, h) do { _Pragma("unroll") for (int n = 0; n < 2; ++n) _Pragma("unroll") for (int k = 0; k < 2; ++k) dst[n][k] = *(const LAS bf16x8*)(lds + PG8_SB(b, h) + boff + n * 2048 + k * 1024); } while (0)
#define PG8_MMA(ai, bj, At, Bt) do { __builtin_amdgcn_s_setprio(1); _Pragma("unroll") for (int m = 0; m < 4; ++m) _Pragma("unroll") for (int n = 0; n < 2; ++n) _Pragma("unroll") for (int k = 0; k < 2; ++k) \
        acc[ai][bj][m][n] = __builtin_amdgcn_mfma_f32_16x16x32_bf16(Bt[n][k], At[m][k], acc[ai][bj][m][n], 0, 0, 0); __builtin_amdgcn_s_setprio(0); } while (0)
#define PG8_WAIT_V(n) asm volatile("s_waitcnt vmcnt(" #n ")" ::: "memory")
#define PG8_WAIT_L(n) asm volatile("s_waitcnt lgkmcnt(" #n ")" ::: "memory")
#define PG8_BAR __builtin_amdgcn_s_barrier()
#define PG8_SCHED __builtin_amdgcn_sched_barrier(0)
    Unit cur, nxt; int ui = 0;
    if (!S.next(0, cur)) return;
    f32x4 acc[2][2][4][2];
#pragma unroll
    for (int a = 0; a < 2; ++a)
#pragma unroll
        for (int b = 0; b < 2; ++b)
#pragma unroll
            for (int m = 0; m < 4; ++m)
#pragma unroll
                for (int n = 0; n < 2; ++n) acc[a][b][m][n] = (f32x4){0.f, 0.f, 0.f, 0.f};
    bf16x8 At[4][2], B0[2][2], B1[2][2];
    const char* cA = (const char*)g.A + (size_t)cur.pm * tstep; const char* cB = (const char*)g.Bt + (size_t)cur.pn * tstep;
    PG8_STAGE(PG8_SB(0, 0), cB, voffB); PG8_STAGE(PG8_SB(0, 1), cB + hstep, voffB); PG8_STAGE(PG8_SA(0, 0), cA, voffA); PG8_STAGE(PG8_SA(0, 1), cA + hstep, voffA);
    if (wr == 1) PG8_BAR;
    PG8_WAIT_V(2); PG8_BAR;
    PG8_STAGE(PG8_SB(1, 0), cB + kstep, voffB); PG8_STAGE(PG8_SA(1, 0), cA + kstep, voffA); PG8_STAGE(PG8_SB(1, 1), cB + hstep + kstep, voffB);
    PG8_WAIT_V(6); PG8_BAR;
    for (;;) {
        const bool has_next = S.next(ui + 1, nxt);
        const char* nA = has_next ? (const char*)g.A + (size_t)nxt.pm * tstep : cA; const char* nB = has_next ? (const char*)g.Bt + (size_t)nxt.pn * tstep : cB;
        for (int t = 0; t < nt; t += 2) {
            const bool last = (t == nt - 2);
            const char* a1 = cA + (size_t)(t + 1) * kstep;
            const char* a2 = last ? nA : cA + (size_t)(t + 2) * kstep; const char* b2 = last ? nB : cB + (size_t)(t + 2) * kstep;
            const char* a3 = a2 + kstep; const char* b3 = b2 + kstep;
            PG8_LDB(B0, 0, 0); PG8_LDB(B1, 0, 1); PG8_SCHED; PG8_LDA(At, 0, 0); PG8_STAGE(PG8_SA(1, 1), a1 + hstep, voffA);
            PG8_WAIT_V(8); PG8_WAIT_L(0); PG8_BAR; PG8_MMA(0, 0, At, B0); PG8_MMA(0, 1, At, B1); PG8_BAR; PG8_SCHED;
            PG8_LDA(At, 0, 1); PG8_STAGE(PG8_SB(0, 0), b2, voffB); PG8_STAGE(PG8_SB(0, 1), b2 + hstep, voffB); PG8_STAGE(PG8_SA(0, 0), a2, voffA);
            PG8_WAIT_V(8); PG8_WAIT_L(0); PG8_BAR; PG8_MMA(1, 0, At, B0); PG8_MMA(1, 1, At, B1); PG8_BAR; PG8_SCHED;
            PG8_LDB(B0, 1, 0); PG8_LDB(B1, 1, 1); PG8_SCHED; PG8_LDA(At, 1, 0); PG8_STAGE(PG8_SA(0, 1), a2 + hstep, voffA);
            PG8_WAIT_V(8); PG8_WAIT_L(0); PG8_BAR; PG8_MMA(0, 0, At, B0); PG8_MMA(0, 1, At, B1); PG8_BAR; PG8_SCHED;
            PG8_LDA(At, 1, 1); PG8_STAGE(PG8_SB(1, 0), b3, voffB); PG8_STAGE(PG8_SB(1, 1), b3 + hstep, voffB); PG8_STAGE(PG8_SA(1, 0), a3, voffA);
            PG8_WAIT_V(8); PG8_WAIT_L(0); PG8_BAR; PG8_MMA(1, 0, At, B0); PG8_MMA(1, 1, At, B1); PG8_BAR; PG8_SCHED;
        }
        if (wr == 0) PG8_BAR;
        E(acc, cur, wr, wc, fr, fq);
        if (!has_next) break;
#pragma unroll
        for (int a = 0; a < 2; ++a)
#pragma unroll
            for (int b = 0; b < 2; ++b)
#pragma unroll
                for (int m = 0; m < 4; ++m)
#pragma unroll
                    for (int n = 0; n < 2; ++n) acc[a][b][m][n] = (f32x4){0.f, 0.f, 0.f, 0.f};
        cur = nxt; cA = nA; cB = nB; ++ui;
        if (wr == 1) PG8_BAR;
    }
    PG8_WAIT_V(0);
    PG8_BAR;
#undef PG8_SA
#undef PG8_SB
#undef PG8_STAGE
#undef PG8_LDA
#undef PG8_LDB
#undef PG8_MMA
#undef PG8_WAIT_V
#undef PG8_WAIT_L
#undef PG8_BAR
#undef PG8_SCHED
}
}

typedef f32x4 AccT[2][2][4][2];

struct EpiStore {
    bf16_t* O; int ldc;
    DI void operator()(const AccT& acc, const pg8::Unit& u, int wr, int wc, int fr, int fq) const {
        const int row0 = u.pm * 256 + wr * 64 + fr, col0 = u.pn * 256 + wc * 32 + 8 * fq;
#pragma unroll
        for (int ai = 0; ai < 2; ++ai)
#pragma unroll
            for (int m = 0; m < 4; ++m) { bf16_t* rowp = O + (size_t)(row0 + ai * 128 + m * 16) * ldc + col0;
#pragma unroll
                for (int bj = 0; bj < 2; ++bj) *(GAS u32x4*)(rowp + bj * 128) = pack8(acc[ai][bj][m][0], acc[ai][bj][m][1]); }
    }
};
struct EpiSwiGLU {
    bf16_t* O;
    DI void operator()(const AccT& acc, const pg8::Unit& u, int wr, int wc, int fr, int fq) const {
        const int row0 = u.pm * 256 + wr * 64 + fr, col0 = u.pn * 128 + wc * 32 + 8 * fq;
#pragma unroll
        for (int ai = 0; ai < 2; ++ai)
#pragma unroll
            for (int m = 0; m < 4; ++m) {
                f32x4 r[2];
#pragma unroll
                for (int n = 0; n < 2; ++n)
#pragma unroll
                    for (int j = 0; j < 4; ++j) { const float gv = acc[ai][0][m][n][j], uv = acc[ai][1][m][n][j];
                        r[n][j] = gv * __builtin_amdgcn_rcpf(1.f + __builtin_amdgcn_exp2f(-gv * LOG2E)) * uv; }
                *(GAS u32x4*)(O + (size_t)(row0 + ai * 128 + m * 16) * FF + col0) = pack8(r[0], r[1]);
            }
    }
};
struct EpiQK {
    bf16_t* Q; long long kdelta; const f32x2* rope; int mode; float qscale;
    DI void operator()(const AccT& acc, const pg8::Unit& u, int wr, int wc, int fr, int fq) const {
        const int rt0 = u.pm * 256, b = rt0 / TPB, pt0 = rt0 - b * TPB, pbase = pt0 + wr * 64 + fr;
        const bool lat = pt0 >= CTX;
        const int pn = u.pn;
        const bool roped = (mode == 0) || (mode == 1 && pn >= 4);
        const int dqk = (mode == 1 || mode == 2) ? 96 : 64;
        const bool toK = (mode == 2) || ((mode == 0 || mode == 3) && pn >= 4);
        bf16_t* dst = Q + (toK ? kdelta : 0ll);
        const float qs = toK ? 1.f : qscale;
        if (!roped) {
#pragma unroll
            for (int bj = 0; bj < 2; ++bj) {
                const int head = 4 * (pn & 3) + 2 * bj + (wc >> 1), d0 = 32 * (wc & 1) + 8 * fq;
                bf16_t* hp = dst + ((size_t)(b * 16 + head) * TPB + pbase) * dqk + d0;
#pragma unroll
                for (int ai = 0; ai < 2; ++ai)
#pragma unroll
                    for (int m = 0; m < 4; ++m) *(GAS u32x4*)(hp + (size_t)(ai * 128 + m * 16) * dqk) = pack8(acc[ai][bj][m][0] * qs, acc[ai][bj][m][1] * qs);
            }
        } else {
            int head, i0, half, doff, rtw;
            if (mode == 0) { head = (pn & 3) * 4 + wc; i0 = 8 * fq; half = 32; doff = 0; rtw = 32; }
            else { head = 8 * (pn - 4) + 2 * wc + (fq >> 1); i0 = 8 * (fq & 1); half = 16; doff = 64; rtw = 16; }
            bf16_t* hp = dst + ((size_t)(b * 16 + head) * TPB + pbase) * dqk + doff + i0;
#pragma unroll
            for (int ai = 0; ai < 2; ++ai)
#pragma unroll
                for (int m = 0; m < 4; ++m) {
                    const int dp = ai * 128 + m * 16;
                    f32x4 a0 = acc[ai][0][m][0], a1 = acc[ai][0][m][1], b0 = acc[ai][1][m][0], b1 = acc[ai][1][m][1];
                    f32x4 o10, o11, o20, o21;
                    if (lat) {
                        const GAS f32x4* cs = (const GAS f32x4*)(rope + (size_t)(pbase + dp - CTX) * rtw + i0);
                        const f32x4 c01 = cs[0], c23 = cs[1], c45 = cs[2], c67 = cs[3];
                        o10[0] = a0[0] * c01[0] - b0[0] * c01[1]; o20[0] = a0[0] * c01[1] + b0[0] * c01[0];
                        o10[1] = a0[1] * c01[2] - b0[1] * c01[3]; o20[1] = a0[1] * c01[3] + b0[1] * c01[2];
                        o10[2] = a0[2] * c23[0] - b0[2] * c23[1]; o20[2] = a0[2] * c23[1] + b0[2] * c23[0];
                        o10[3] = a0[3] * c23[2] - b0[3] * c23[3]; o20[3] = a0[3] * c23[3] + b0[3] * c23[2];
                        o11[0] = a1[0] * c45[0] - b1[0] * c45[1]; o21[0] = a1[0] * c45[1] + b1[0] * c45[0];
                        o11[1] = a1[1] * c45[2] - b1[1] * c45[3]; o21[1] = a1[1] * c45[3] + b1[1] * c45[2];
                        o11[2] = a1[2] * c67[0] - b1[2] * c67[1]; o21[2] = a1[2] * c67[1] + b1[2] * c67[0];
                        o11[3] = a1[3] * c67[2] - b1[3] * c67[3]; o21[3] = a1[3] * c67[3] + b1[3] * c67[2];
                    } else { o10 = a0; o11 = a1; o20 = b0; o21 = b1; }
                    *(GAS u32x4*)(hp + (size_t)dp * dqk) = pack8(o10 * qs, o11 * qs);
                    *(GAS u32x4*)(hp + (size_t)dp * dqk + half) = pack8(o20 * qs, o21 * qs);
                }
        }
    }
};

constexpr int NUNITS = NB * 16 * 33;
template <int DQK, int DV, int NAT, int VSHIFT, int COMB>
__device__ __forceinline__ void attn_phase(LAS unsigned char* lds, const bf16_t* Q, const bf16_t* K, const bf16_t* Vt, bf16_t* O, int ldo, float scale, const float* rpb, int vcu, int G, const int tid,
                                           bf16_t* Hout, const float* gsub, float lam, float oml) {
    constexpr bool DMA = true;
    constexpr bool K128 = DMA && !NAT;
    constexpr int KS = DMA ? (DQK == 64 ? 128 : 256) : DQK * 2 + 16,
         VS = DMA ? 128 : 144, KBYTES = 64 * KS, VBYTES = DV * VS, NSL = K128 ? 4 : 2;
    constexpr int KCH = 8 * DQK, KPT = (KCH + 511) / 512, VCH = DV * 8, VPT = VCH / 512, CPR = DQK / 8;
    constexpr int VOFF = NSL * KBYTES, RPBOFF = NSL * KBYTES + NSL * VBYTES;
    constexpr bool QREG = true;
    constexpr int QOFF = RPBOFF + (NAT ? 2048 : 0), QW = (DQK / 16) * 1024;
    constexpr int NQ = 2 * (DQK / 16), NP2 = 2 * (DV / 32), VPM1 = (48 + NQ - 1) / NQ, VPM2 = (48 + NP2 - 1) / NP2;
    const int lane = tid & 63, w = __builtin_amdgcn_readfirstlane(tid >> 6), n = lane & 31, hh = lane >> 5;
    const int pim = (n & 0x13) | ((n & 4) << 1) | ((n & 8) >> 1);
    LAS float* rpb_s = (LAS float*)(lds + RPBOFF);
    const int swk = (KS == 128) ? ((pim >> 1) & 7) : (pim & 15), swv = (n >> 1) & 7;
#define ATT_KOFF(c) (DMA ? ((((c) ^ swk)) << 4) : ((c) << 4))
#define ATT_VOFFS(c) (DMA ? ((((c) ^ swv)) << 4) : ((c) << 4))
    constexpr int DKPT = KS / 128;
    unsigned dko[DKPT], dvo[DV / 64];
    { const int r_ = w * 8 + (lane >> 3);
#pragma unroll
      for (int i_ = 0; i_ < DKPT; ++i_) { const int cpr = KS / 16, rk = i_ * (8192 / KS) + w * (1024 / KS) + lane / cpr, cp = lane % cpr, sw = (KS == 128) ? ((rk >> 1) & 7) : (rk & 15);
          dko[i_] = (unsigned)(rk * DQK * 2 + (cp ^ sw) * 16); }
#pragma unroll
      for (int i_ = 0; i_ < DV / 64; ++i_) { const int rv = i_ * 64 + r_; dvo[i_] = (unsigned)(rv * MTOT + ((lane & 7) ^ ((rv >> 1) & 7)) * 8) * 2u; } }
    unsigned lvo[VPT];
#pragma unroll
    for (int p = 0; p < VPT; ++p) { const int c = tid + 512 * p; lvo[p] = (unsigned)(((c >> 3) * MTOT + (c & 7) * 8) * 2); }
    (void)scale;
    constexpr int NU = COMB ? NB * 8 * 33 : NUNITS, NBIG = COMB ? 1024 : 2048;
    for (int ui = vcu; ui < NU; ui += G) {
        int bx_, qb;
        if (ui < NBIG) { bx_ = ui >> 5; qb = 1 + (ui & 31); } else { bx_ = ui - NBIG; qb = 0; }
#pragma unroll 1
      for (int s2 = 0; s2 < (COMB ? 2 : 1); ++s2) {
        const int bv = COMB ? ((bx_ >> 3) * 16 + (bx_ & 7) * 2 + s2) : bx_;
        const int b = bv >> 4, vh = bv & 15, hv = vh >> VSHIFT;
        const bf16_t* Kb = K + (size_t)bv * TPB * DQK;
        const bf16_t* Vb = Vt + (size_t)hv * DV * MTOT + (size_t)b * TPB;
        int nkt, lo = 0;
        if (qb == 0) nkt = 4;
        else if (!NAT) nkt = TPB / 64;
        else { const int r0 = (qb - 1) * 4; lo = min(max(r0 - 4, 0), 120); const int hi = min(max(r0 - 1, 0), 120) + 8; nkt = 4 + hi - lo; }
        const int pos_q = qb * 256 + w * 32 + n;
        const int qr = (qb - 1) * 4 + (w >> 1), qrs = min(max(qr - 4, 0), 120);
        int lq_ = lane; asm volatile("" : "+v"(lq_));
        const bf16_t* qp = Q + ((size_t)bv * TPB + qb * 256 + w * 32 + (lq_ & 31)) * DQK + (lq_ >> 5) * 8;
        bf16x8 qg[DQK / 16];
#pragma unroll
        for (int ks = 0; ks < DQK / 16; ++ks) qg[ks] = *(const GAS bf16x8*)(qp + ks * 16);
        LAS unsigned char* qs = lds + QOFF + w * QW + lane * 16;
        f32x16 o[DV / 32];
#pragma unroll
        for (int dt = 0; dt < DV / 32; ++dt)
#pragma unroll
            for (int i = 0; i < 16; ++i) o[dt][i] = 0.f;
        float l_run = 0.f;
        f32x16 negm;
#pragma unroll
        for (int i = 0; i < 16; ++i) negm[i] = 0.f;
        u32x4 kr[KPT], vr[VPT];
#define ATT_KEY0(kt) ((!NAT || (kt) < 4) ? (kt) * 64 : CTX + (lo + (kt) - 4) * 64)
#define ATT_ACTIVE(kt) (!(NAT && (kt) >= 4) || ((lo + (kt) - 4 >= qrs) && (lo + (kt) - 4 < qrs + 8)))
#define ATT_LOADK(kt) do { const int k0_ = ATT_KEY0(kt); \
        _Pragma("unroll") for (int p = 0; p < KPT; ++p) { const int c = tid + 512 * p; if (c < KCH) kr[p] = *(const GAS u32x4*)((const GAS char*)(Kb + (size_t)k0_ * DQK) + (unsigned)(c * 16)); } } while (0)
#define ATT_LOADV(kt) do { const int k0_ = ATT_KEY0(kt); \
        _Pragma("unroll") for (int p = 0; p < VPT; ++p) vr[p] = *(const GAS u32x4*)((const GAS char*)(Vb + k0_) + lvo[p]); } while (0)
#define ATT_STOREK(buf) do { \
        _Pragma("unroll") for (int p = 0; p < KPT; ++p) { const int c = tid + 512 * p; if (c < KCH) *(LAS u32x4*)(lds + (buf) * KBYTES + (c / CPR) * KS + (c % CPR) * 16) = kr[p]; } } while (0)
#define ATT_STOREV(buf) do { \
        _Pragma("unroll") for (int p = 0; p < VPT; ++p) { const int c = tid + 512 * p; *(LAS u32x4*)(lds + VOFF + (buf) * VBYTES + (c >> 3) * VS + (c & 7) * 16) = vr[p]; } } while (0)
#define ATT_DMAK(kt, slot) do { const int k0_ = ATT_KEY0(kt); \
        _Pragma("unroll") for (int i_ = 0; i_ < DKPT; ++i_) \
            __builtin_amdgcn_global_load_lds((const unsigned*)((const char*)(Kb + (size_t)k0_ * DQK) + dko[i_]), (LAS unsigned*)(lds + (slot) * KBYTES + i_ * 8192 + w * 1024), 16, 0, 0); } while (0)
#define ATT_DMAV(kt, slot) do { const int k0_ = ATT_KEY0(kt); \
        _Pragma("unroll") for (int i_ = 0; i_ < DV / 64; ++i_) \
            __builtin_amdgcn_global_load_lds((const unsigned*)((const char*)(Vb + k0_) + dvo[i_]), (LAS unsigned*)(lds + VOFF + (slot) * VBYTES + i_ * 8192 + w * 1024), 16, 0, 0); } while (0)
#define ATT_QK(sa, sb, buf) do { LAS const unsigned char* kb_ = lds + (buf) * KBYTES; \
        bf16x8 ka_[DQK / 16], kc_[DQK / 16], qf[DQK / 16]; \
        _Pragma("unroll") for (int ks = 0; ks < DQK / 16; ++ks) { \
            qf[ks] = QREG ? qg[ks] : *(LAS const bf16x8*)(qs + ks * 1024); \
            ka_[ks] = *(LAS const bf16x8*)(kb_ + pim * KS + ATT_KOFF(2 * ks + hh)); \
            kc_[ks] = *(LAS const bf16x8*)(kb_ + (32 + pim) * KS + ATT_KOFF(2 * ks + hh)); } \
        __builtin_amdgcn_sched_barrier(0); \
        sa = __builtin_amdgcn_mfma_f32_32x32x16_bf16(ka_[0], qf[0], negm, 0, 0, 0); \
        sb = __builtin_amdgcn_mfma_f32_32x32x16_bf16(kc_[0], qf[0], negm, 0, 0, 0); \
        _Pragma("unroll") for (int ks = 1; ks < DQK / 16; ++ks) { \
            sa = __builtin_amdgcn_mfma_f32_32x32x16_bf16(ka_[ks], qf[ks], sa, 0, 0, 0); \
            sb = __builtin_amdgcn_mfma_f32_32x32x16_bf16(kc_[ks], qf[ks], sb, 0, 0, 0); } \
        __builtin_amdgcn_sched_barrier(0); } while (0)
#define ATT_MASK(s0, s1, kt) do { \
        const int krow = lo + (kt) - 4; const bool rin = (krow >= qrs) && (krow < qrs + 8); \
        const int cq = (w & 1) * 32 + n, cst = min(max(cq - 8, 0), 48); \
        LAS const float* bp = rpb_s + (rin ? (krow - qr + 7) : 0) * 31 - cq + 15; \
        _Pragma("unroll") for (int i = 0; i < 16; ++i) { \
            const int kc0 = 16 * (i >> 3) + 8 * hh + (i & 7), kc1 = kc0 + 32; \
            const bool v0 = rin && (kc0 >= cst) && (kc0 < cst + 16), v1 = rin && (kc1 >= cst) && (kc1 < cst + 16); \
            const float b0 = v0 ? bp[kc0] : 0.f, b1 = v1 ? bp[kc1] : 0.f; \
            s0[i] = v0 ? (s0[i] + b0 * LOG2E) : -1e30f; \
            s1[i] = v1 ? (s1[i] + b1 * LOG2E) : -1e30f; } } while (0)
#define ATT_SOFT_FAST(sv, pa, pb, lsum) do { float l0_ = 0.f; \
        _Pragma("unroll") for (int i = 0; i < 4; ++i) { \
            const float e0 = __builtin_amdgcn_exp2f(sv[2 * i]), e1 = __builtin_amdgcn_exp2f(sv[2 * i + 1]), e2 = __builtin_amdgcn_exp2f(sv[8 + 2 * i]), e3 = __builtin_amdgcn_exp2f(sv[9 + 2 * i]); \
            l0_ += e0; l0_ += e1; l0_ += e2; l0_ += e3; pa[i] = pk2(e0, e1); pb[i] = pk2(e2, e3); } \
        lsum = l0_; } while (0)
#define ATT_SOFT_SLOW(sv, pa, pb, lsum, first, ADJ) do { \
        float d_ = fmaxf(fmaxf(sv[0], sv[1]), fmaxf(sv[2], sv[3])); \
        _Pragma("unroll") for (int i = 4; i < 16; i += 2) d_ = fmaxf(d_, fmaxf(sv[i], sv[i + 1])); \
        d_ = fmaxf(d_, __shfl_xor(d_, 32)); \
        const float delta = (first) ? d_ : fmaxf(d_, 0.f); \
        if (!(first)) { const float alpha = __builtin_amdgcn_exp2f(-delta); l_run *= alpha; \
            _Pragma("unroll") for (int dt = 0; dt < DV / 32; ++dt) _Pragma("unroll") for (int i = 0; i < 16; ++i) o[dt][i] *= alpha; } \
        _Pragma("unroll") for (int i = 0; i < 16; ++i) { sv[i] -= delta; ADJ; negm[i] -= delta; } \
        float l2 = 0.f; \
        _Pragma("unroll") for (int i = 0; i < 4; ++i) { \
            const float e0 = __builtin_amdgcn_exp2f(sv[2 * i]), e1 = __builtin_amdgcn_exp2f(sv[2 * i + 1]), e2 = __builtin_amdgcn_exp2f(sv[8 + 2 * i]), e3 = __builtin_amdgcn_exp2f(sv[9 + 2 * i]); \
            l2 += (e0 + e1) + (e2 + e3); pa[i] = pk2(e0, e1); pb[i] = pk2(e2, e3); } \
        lsum = l2; } while (0)
#define ATT_PIN(v_) do { asm volatile("" : "+v"(v_.x)); asm volatile("" : "+v"(v_.y)); asm volatile("" : "+v"(v_.z)); asm volatile("" : "+v"(v_.w)); } while (0)
#define ATT_STEP(sc0, sc1, sn0, sn1, kt, PAR) do { \
        if (K128) { if ((PAR) == 0) { if ((kt) + 3 < nkt) ATT_DMAK((kt) + 3, ((kt) + 3) & 3); if ((kt) + 4 < nkt) ATT_DMAK((kt) + 4, (kt) & 3); }     \
                    else { if ((kt) + 1 < nkt) ATT_DMAV((kt) + 1, ((kt) + 1) & 3); if ((kt) + 2 < nkt) ATT_DMAV((kt) + 2, ((kt) + 2) & 3); } } \
        else if (DMA) { if ((kt) + 2 < nkt) ATT_DMAK((kt) + 2, (kt) & 1); if ((kt) + 1 < nkt) ATT_DMAV((kt) + 1, ((kt) + 1) & 1); } \
        else { if ((kt) + 2 < nkt) ATT_LOADK((kt) + 2); if ((kt) + 1 < nkt) ATT_LOADV((kt) + 1); } \
        if (NAT && (kt) >= 4) ATT_MASK(sc0, sc1, kt); \
        u32x4 pq0, pq1, pq2, pq3; float lsA, lsB; \
        { LAS const unsigned char* kb_ = lds + (((kt) + 1) & (NSL - 1)) * KBYTES; \
          bf16x8 ka_[DQK / 16], kc_[DQK / 16], qf[DQK / 16]; \
          _Pragma("unroll") for (int ks = 0; ks < DQK / 16; ++ks) { \
              qf[ks] = QREG ? qg[ks] : *(LAS const bf16x8*)(qs + ks * 1024); \
              ka_[ks] = *(LAS const bf16x8*)(kb_ + pim * KS + ATT_KOFF(2 * ks + hh)); \
              kc_[ks] = *(LAS const bf16x8*)(kb_ + (32 + pim) * KS + ATT_KOFF(2 * ks + hh)); } \
          sn0 = __builtin_amdgcn_mfma_f32_32x32x16_bf16(ka_[0], qf[0], negm, 0, 0, 0); \
          sn1 = __builtin_amdgcn_mfma_f32_32x32x16_bf16(kc_[0], qf[0], negm, 0, 0, 0); \
          _Pragma("unroll") for (int ks = 1; ks < DQK / 16; ++ks) { \
              sn0 = __builtin_amdgcn_mfma_f32_32x32x16_bf16(ka_[ks], qf[ks], sn0, 0, 0, 0); \
              sn1 = __builtin_amdgcn_mfma_f32_32x32x16_bf16(kc_[ks], qf[ks], sn1, 0, 0, 0); } \
          ATT_SOFT_FAST(sc0, pq0, pq1, lsA); if (DV == 64) { ATT_PIN(pq0); ATT_PIN(pq1); }     \
          __builtin_amdgcn_sched_group_barrier(0x100, QREG ? 4 : 6, 0); \
          _Pragma("unroll") for (int ks = 0; ks < DQK / 16; ++ks) { \
              __builtin_amdgcn_sched_group_barrier(0x008, 1, 0); __builtin_amdgcn_sched_group_barrier(0x002, VPM1, 0); \
              __builtin_amdgcn_sched_group_barrier(0x008, 1, 0); __builtin_amdgcn_sched_group_barrier(0x002, VPM1, 0); \
              if (ks + 2 < DQK / 16) __builtin_amdgcn_sched_group_barrier(0x100, QREG ? 2 : 3, 0); } \
          __builtin_amdgcn_sched_barrier(0); } \
        if (__builtin_amdgcn_ballot_w64(((kt) == 0) || !(lsA < 1e18f)) != 0ull) ATT_SOFT_SLOW(sc0, pq0, pq1, lsA, (kt) == 0, sc1[i] -= delta; sn0[i] -= delta; sn1[i] -= delta); \
        l_run += lsA; \
        LAS const unsigned char* vb_ = lds + VOFF + ((kt) & (NSL - 1)) * VBYTES; \
        { const bf16x8 pf0 = __builtin_bit_cast(bf16x8, pq0), pf1 = __builtin_bit_cast(bf16x8, pq1); \
          bf16x8 vf_[DV / 32][2]; \
          _Pragma("unroll") for (int dt = 0; dt < DV / 32; ++dt) _Pragma("unroll") for (int kk = 0; kk < 2; ++kk) \
              vf_[dt][kk] = *(LAS const bf16x8*)(vb_ + (dt * 32 + n) * VS + ATT_VOFFS(2 * kk + hh)); \
          _Pragma("unroll") for (int dt = 0; dt < DV / 32; ++dt) { \
              o[dt] = __builtin_amdgcn_mfma_f32_32x32x16_bf16(vf_[dt][0], pf0, o[dt], 0, 0, 0); \
              o[dt] = __builtin_amdgcn_mfma_f32_32x32x16_bf16(vf_[dt][1], pf1, o[dt], 0, 0, 0); } \
          ATT_SOFT_FAST(sc1, pq2, pq3, lsB); if (DV == 64) { ATT_PIN(pq2); ATT_PIN(pq3); } \
          __builtin_amdgcn_sched_group_barrier(0x100, NP2, 0); \
          _Pragma("unroll") for (int i = 0; i < NP2; ++i) { __builtin_amdgcn_sched_group_barrier(0x008, 1, 0); __builtin_amdgcn_sched_group_barrier(0x002, VPM2, 0); } \
          __builtin_amdgcn_sched_barrier(0); } \
        if (__builtin_amdgcn_ballot_w64(!(lsB < 1e18f)) != 0ull) ATT_SOFT_SLOW(sc1, pq2, pq3, lsB, false, sn0[i] -= delta; sn1[i] -= delta); \
        l_run += lsB; \
        { const bf16x8 pf2 = __builtin_bit_cast(bf16x8, pq2), pf3 = __builtin_bit_cast(bf16x8, pq3); \
          bf16x8 vf_[DV / 32][2]; \
          _Pragma("unroll") for (int dt = 0; dt < DV / 32; ++dt) _Pragma("unroll") for (int kk = 0; kk < 2; ++kk) \
              vf_[dt][kk] = *(LAS const bf16x8*)(vb_ + (dt * 32 + n) * VS + ATT_VOFFS(2 * (kk + 2) + hh)); \
          __builtin_amdgcn_sched_barrier(0); __builtin_amdgcn_s_setprio(1); \
          _Pragma("unroll") for (int dt = 0; dt < DV / 32; ++dt) { \
              o[dt] = __builtin_amdgcn_mfma_f32_32x32x16_bf16(vf_[dt][0], pf2, o[dt], 0, 0, 0); \
              o[dt] = __builtin_amdgcn_mfma_f32_32x32x16_bf16(vf_[dt][1], pf3, o[dt], 0, 0, 0); } \
          __builtin_amdgcn_s_setprio(0); __builtin_amdgcn_sched_barrier(0); } \
        if (K128) { if ((PAR) == 1) { asm volatile("s_waitcnt vmcnt(0)" ::: "memory"); __syncthreads(); } } \
        else if (DMA) { asm volatile("s_waitcnt vmcnt(0)" ::: "memory"); __syncthreads(); } \
        else { if ((kt) + 2 < nkt) ATT_STOREK((kt) & 1); if ((kt) + 1 < nkt) ATT_STOREV(((kt) + 1) & 1); __syncthreads(); } } while (0)
        __syncthreads();
        if (NAT) { for (int i = tid; i < 465; i += 512) rpb_s[i] = rpb[vh * 465 + i]; }
#pragma unroll
        for (int ks = 0; ks < DQK / 16; ++ks) { if (!QREG) *(LAS bf16x8*)(qs + ks * 1024) = qg[ks]; }
        if (K128) { ATT_DMAK(0, 0); ATT_DMAV(0, 0); ATT_DMAK(1, 1); ATT_DMAV(1, 1); ATT_DMAK(2, 2); asm volatile("s_waitcnt vmcnt(0)" ::: "memory"); }
        else if (DMA) { ATT_DMAK(0, 0); ATT_DMAV(0, 0); ATT_DMAK(1, 1); asm volatile("s_waitcnt vmcnt(0)" ::: "memory"); }
        else { ATT_LOADK(0); ATT_STOREK(0); ATT_LOADV(0); ATT_STOREV(0); ATT_LOADK(1); ATT_STOREK(1); }
        __syncthreads();
        f32x16 sA0, sA1, sB0, sB1;
        ATT_QK(sA0, sA1, 0);
        __syncthreads();
        for (int kt = 0; kt < nkt; kt += 2) {
            ATT_STEP(sA0, sA1, sB0, sB1, kt, 0);
            if (kt + 1 < nkt) ATT_STEP(sB0, sB1, sA0, sA1, kt + 1, 1);
        }
        const float lt = l_run + __shfl_xor(l_run, 32), inv = 1.f / lt;
        int lf_ = lane; asm volatile("" : "+v"(lf_));
        const int nf_ = lf_ & 31, hf_ = lf_ >> 5, posf_ = qb * 256 + w * 32 + nf_;
#define ATT_SWAP(a_, b_) do { const u32x2 r_ = __builtin_amdgcn_permlane32_swap((a_), (b_), false, false); (a_) = r_[0]; (b_) = r_[1]; } while (0)
        bf16_t* op = O + (size_t)(b * TPB + posf_) * ldo + vh * DV + 8 * hf_;
        if (COMB && s2 == 1) {
            const bf16_t* o1p = op - DV;
            float ss = 0.f;
#pragma unroll
            for (int dt = 0; dt < DV / 32; ++dt)
#pragma unroll
                for (int j = 0; j < 2; ++j) {
                    u32x4 r1 = *(const GAS u32x4*)(o1p + dt * 32 + 16 * j);
                    ATT_SWAP(r1.x, r1.z); ATT_SWAP(r1.y, r1.w);
#pragma unroll
                    for (int q = 0; q < 2; ++q) { const int g4 = 2 * j + q; const unsigned lo_ = q ? r1.z : r1.x, hi_ = q ? r1.w : r1.y;
                        const float d0 = bflo(lo_) - lam * (o[dt][4 * g4] * inv), d1 = bfhi(lo_) - lam * (o[dt][4 * g4 + 1] * inv);
                        const float d2 = bflo(hi_) - lam * (o[dt][4 * g4 + 2] * inv), d3 = bfhi(hi_) - lam * (o[dt][4 * g4 + 3] * inv);
                        o[dt][4 * g4] = d0; o[dt][4 * g4 + 1] = d1; o[dt][4 * g4 + 2] = d2; o[dt][4 * g4 + 3] = d3;
                        ss += (d0 * d0 + d1 * d1) + (d2 * d2 + d3 * d3); }
                }
            ss += __shfl_xor(ss, 32);
            const float rs = rsqrtf(ss * (1.f / 128.f) + EPS) * oml;
            bf16_t* hp = Hout + (size_t)(b * TPB + posf_) * D + (vh >> 1) * DV + 8 * hf_;
#pragma unroll
            for (int dt = 0; dt < DV / 32; ++dt)
#pragma unroll
                for (int j = 0; j < 2; ++j) {
                    const f32x4 ga = *(const GAS f32x4*)((const GAS char*)gsub + (unsigned)((dt * 32 + 16 * j + 4 * hf_) * 4)), gb = *(const GAS f32x4*)((const GAS char*)gsub + (unsigned)((dt * 32 + 16 * j + 8 + 4 * hf_) * 4));
                    u32x4 wv;
                    wv.x = pk2(o[dt][8 * j] * rs * ga[0], o[dt][8 * j + 1] * rs * ga[1]); wv.y = pk2(o[dt][8 * j + 2] * rs * ga[2], o[dt][8 * j + 3] * rs * ga[3]);
                    wv.z = pk2(o[dt][8 * j + 4] * rs * gb[0], o[dt][8 * j + 5] * rs * gb[1]); wv.w = pk2(o[dt][8 * j + 6] * rs * gb[2], o[dt][8 * j + 7] * rs * gb[3]);
                    ATT_SWAP(wv.x, wv.z); ATT_SWAP(wv.y, wv.w);
                    *(GAS u32x4*)(hp + dt * 32 + 16 * j) = wv;
                }
        } else {
#pragma unroll
            for (int dt = 0; dt < DV / 32; ++dt)
#pragma unroll
                for (int j = 0; j < 2; ++j) {
                    u32x4 wv;
                    wv.x = pk2(o[dt][8 * j] * inv, o[dt][8 * j + 1] * inv); wv.y = pk2(o[dt][8 * j + 2] * inv, o[dt][8 * j + 3] * inv);
                    wv.z = pk2(o[dt][8 * j + 4] * inv, o[dt][8 * j + 5] * inv); wv.w = pk2(o[dt][8 * j + 6] * inv, o[dt][8 * j + 7] * inv);
                    ATT_SWAP(wv.x, wv.z); ATT_SWAP(wv.y, wv.w);
                    *(GAS u32x4*)(op + dt * 32 + 16 * j) = wv;
                }
        }
#undef ATT_SWAP
#undef ATT_KEY0
#undef ATT_ACTIVE
#undef ATT_LOADK
#undef ATT_LOADV
#undef ATT_STOREK
#undef ATT_STOREV
#undef ATT_QK
#undef ATT_DMAK
#undef ATT_DMAV
#undef ATT_MASK
#undef ATT_SOFT_FAST
#undef ATT_SOFT_SLOW
#undef ATT_STEP
      }
    }
}


#define XB_TMO      128
#define XB_XCNT(j)  (256  + 64 * (j))
#define XB_XSUB(j)  (1280 + 64 * (j))
#define XB_XGEN(j)  (2304 + 64 * (j))
#define XB_TOP      3328
#define XB_TOPGEN   3392
#define XCD_BAR_WORDS 3456
#define XB_SPIN_CAP (1u << 18)
DI unsigned xb_ld(unsigned* p)              { return __hip_atomic_load(p, __ATOMIC_RELAXED, __HIP_MEMORY_SCOPE_AGENT); }
DI unsigned xb_add(unsigned* p, unsigned v) { return __hip_atomic_fetch_add(p, v, __ATOMIC_RELAXED, __HIP_MEMORY_SCOPE_AGENT); }
DI unsigned xb_xcc_id() { return (unsigned)__builtin_amdgcn_s_getreg((3 << 11) | 20) & 0xFu; }
#define XB_SPIN(cond, bar) do { unsigned _sp = 0; while (cond) { __builtin_amdgcn_s_sleep(1); \
    if ((++_sp & 255u) == 0u) { if (xb_ld(&(bar)[XB_TMO])) break; if (_sp > XB_SPIN_CAP) { atomicAdd(&(bar)[XB_TMO], 1u); break; } } } } while (0)
struct XcdBarrier { unsigned* bar; unsigned x; volatile LAS unsigned* st; };
DI void xcd_barrier_complete(unsigned* bar, unsigned x, unsigned& nloc, unsigned& nx) {
    const unsigned G = gridDim.x * gridDim.y * gridDim.z;
    unsigned sum, cnt, mine, sp = 0u;
    for (;;) {
        sum = 0u; cnt = 0u; mine = 0u;
#pragma unroll
        for (unsigned j = 0; j < 16; ++j) { const unsigned c = xb_ld(&bar[XB_XCNT(j)]); sum += c; cnt += (c > 0u) ? 1u : 0u; mine = (j == x) ? c : mine; }
        if (sum == G) break;
        __builtin_amdgcn_s_sleep(1);
        if ((++sp & 255u) == 0u) { if (xb_ld(&bar[XB_TMO])) break; if (sp > XB_SPIN_CAP) { atomicAdd(&bar[XB_TMO], 1u); break; } }
    }
    nloc = mine > 0u ? mine : 1u; nx = cnt > 0u ? cnt : 1u;
}
DI void xcd_barrier(const XcdBarrier& b) {
    asm volatile("s_waitcnt vmcnt(0)" ::: "memory");
    __syncthreads();
    if (threadIdx.x == 0) {
        unsigned* bar = b.bar;
        __builtin_amdgcn_s_waitcnt(0);
        unsigned nloc = b.st[0], nx = b.st[1];
        if (nloc == 0u) { xcd_barrier_complete(bar, b.x, nloc, nx); b.st[0] = nloc; b.st[1] = nx; }
        const unsigned old = xb_add(&bar[XB_XSUB(b.x)], 1u);
        const unsigned gen = old / nloc;
        if (old + 1u == (gen + 1u) * nloc) {
            __builtin_amdgcn_fence(__ATOMIC_RELEASE, "agent");
            asm volatile("s_waitcnt vmcnt(0)" ::: "memory");
            const unsigned og = xb_add(&bar[XB_TOP], 1u);
            const unsigned tg = og / nx;
            if (og + 1u == (tg + 1u) * nx) xb_add(&bar[XB_TOPGEN], 1u);
            else XB_SPIN(xb_ld(&bar[XB_TOPGEN]) == tg, bar);
            __builtin_amdgcn_fence(__ATOMIC_ACQUIRE, "agent");
            xb_add(&bar[XB_XGEN(b.x)], 1u);
            asm volatile("s_waitcnt vmcnt(0)" ::: "memory");
        } else {
            XB_SPIN(xb_ld(&bar[XB_XGEN(b.x)]) == gen, bar);
            __builtin_amdgcn_fence(__ATOMIC_ACQUIRE, "agent");
            asm volatile("s_waitcnt vmcnt(0)" ::: "memory");
        }
    }
    __syncthreads();
}
#define GRID_BAR() do { XcdBarrier xb_; xb_.bar = (unsigned*)p.ws; xb_.x = xb_xcc_id(); xb_.st = (volatile LAS unsigned*)(lds + 131072); xcd_barrier(xb_); } while (0)

struct MatDesc { const float* src; long long dst_off; int K, N, mode, nitems; };
constexpr int NMD = 18;
struct Params { const float* in[41]; float* out; unsigned char* ws; MatDesc md[NMD]; int nmd; int pad; };

__host__ __device__ __forceinline__ int dst_row(int mode, int n) {
    if (mode == 1) {
        if (n >= 2048) return n;
        const int tile = n >> 8, w = n & 255, gq = w >> 6, half = (w >> 5) & 1, i = w & 31; return tile * 256 + half * 128 + gq * 32 + i;
    }
    if (mode == 2) { if (n < FF) return (n >> 7) * 256 + (n & 127); const int m = n - FF; return (m >> 7) * 256 + 128 + (m & 127); }
    if (mode == 3) {
        const int h = n / 96, d = n - h * 96; if (d < 64) return h * 64 + d;
        const int i = d - 64, half = i >> 4, ii = i & 15; return 1024 + (h >> 3) * 256 + half * 128 + (h & 7) * 16 + ii;
    }
    if (mode == 4) { const int h = n >> 7, d = n & 127; return d < 64 ? h * 64 + d : 1024 + h * 64 + (d - 64); }
    return n;
}

DI void transpose_item(const float* W, int K, int N, bf16_t* WT, int mode, LAS float* scr, int item, int lane) {
    const int nblk = N / 32, kb = item / nblk, nb = item - kb * nblk, k0 = 64 * kb, n0 = 32 * nb;
#pragma unroll 8
    for (int i = 0; i < 32; ++i) { const int kk = 2 * i + (lane >> 5); scr[kk * 33 + (lane & 31)] = W[(size_t)(k0 + kk) * N + n0 + (lane & 31)]; }
    asm volatile("s_waitcnt lgkmcnt(0)" ::: "memory");
    const int c = lane & 7;
#pragma unroll
    for (int j = 0; j < 4; ++j) { const int nn = (lane >> 3) + 8 * j; const LAS float* s = scr + (8 * c) * 33 + nn;
        u32x4 o; o.x = pk2(s[0 * 33], s[1 * 33]); o.y = pk2(s[2 * 33], s[3 * 33]); o.z = pk2(s[4 * 33], s[5 * 33]); o.w = pk2(s[6 * 33], s[7 * 33]);
        *(GAS u32x4*)(WT + (size_t)dst_row(mode, n0 + nn) * K + k0 + 8 * c) = o; }
    asm volatile("s_waitcnt lgkmcnt(0)" ::: "memory");
}

DI void row_pass2(int lane, const float* xin, float* X, const bf16_t* Y, const float* gny, const float* gate, bf16_t* H, const float* gnh, const float* sc, const float* sh) {
    f32x4 v[2][4];
#pragma unroll
    for (int r = 0; r < 2; ++r)
#pragma unroll
        for (int j = 0; j < 4; ++j) v[r][j] = ((const GAS f32x4*)(xin + r * D))[64 * j + lane];
    if (Y) {
        u32x2 raw[2][4]; f32x4 gv[4], ga[4];
#pragma unroll
        for (int r = 0; r < 2; ++r)
#pragma unroll
            for (int j = 0; j < 4; ++j) raw[r][j] = ((const GAS u32x2*)(Y + r * D))[64 * j + lane];
#pragma unroll
        for (int j = 0; j < 4; ++j) { gv[j] = ((const GAS f32x4*)gny)[64 * j + lane]; ga[j] = ((const GAS f32x4*)gate)[64 * j + lane]; }
        f32x4 y[2][4]; float ss0 = 0.f, ss1 = 0.f;
#pragma unroll
        for (int j = 0; j < 4; ++j) {
            y[0][j] = (f32x4){bflo(raw[0][j].x), bfhi(raw[0][j].x), bflo(raw[0][j].y), bfhi(raw[0][j].y)};
            y[1][j] = (f32x4){bflo(raw[1][j].x), bfhi(raw[1][j].x), bflo(raw[1][j].y), bfhi(raw[1][j].y)};
            ss0 += (y[0][j][0] * y[0][j][0] + y[0][j][1] * y[0][j][1]) + (y[0][j][2] * y[0][j][2] + y[0][j][3] * y[0][j][3]);
            ss1 += (y[1][j][0] * y[1][j][0] + y[1][j][1] * y[1][j][1]) + (y[1][j][2] * y[1][j][2] + y[1][j][3] * y[1][j][3]); }
#pragma unroll
        for (int o = 1; o < 64; o <<= 1) { ss0 += __shfl_xor(ss0, o); ss1 += __shfl_xor(ss1, o); }
        const float rs0 = rsqrtf(ss0 * (1.f / D) + EPS), rs1 = rsqrtf(ss1 * (1.f / D) + EPS);
#pragma unroll
        for (int j = 0; j < 4; ++j) { const f32x4 gg = ga[j] * gv[j]; v[0][j] += gg * (y[0][j] * rs0); v[1][j] += gg * (y[1][j] * rs1); }
    }
    if (X) {
#pragma unroll
        for (int r = 0; r < 2; ++r)
#pragma unroll
            for (int j = 0; j < 4; ++j) ((GAS f32x4*)(X + r * D))[64 * j + lane] = v[r][j];
    }
    if (H) {
        f32x4 gv[4], sv[4], tv[4];
#pragma unroll
        for (int j = 0; j < 4; ++j) { gv[j] = ((const GAS f32x4*)gnh)[64 * j + lane]; sv[j] = ((const GAS f32x4*)sc)[64 * j + lane]; tv[j] = ((const GAS f32x4*)sh)[64 * j + lane]; }
        float ss0 = 0.f, ss1 = 0.f;
#pragma unroll
        for (int j = 0; j < 4; ++j) {
            ss0 += (v[0][j][0] * v[0][j][0] + v[0][j][1] * v[0][j][1]) + (v[0][j][2] * v[0][j][2] + v[0][j][3] * v[0][j][3]);
            ss1 += (v[1][j][0] * v[1][j][0] + v[1][j][1] * v[1][j][1]) + (v[1][j][2] * v[1][j][2] + v[1][j][3] * v[1][j][3]); }
#pragma unroll
        for (int o = 1; o < 64; o <<= 1) { ss0 += __shfl_xor(ss0, o); ss1 += __shfl_xor(ss1, o); }
        const float rs0 = rsqrtf(ss0 * (1.f / D) + EPS), rs1 = rsqrtf(ss1 * (1.f / D) + EPS);
#pragma unroll
        for (int j = 0; j < 4; ++j) {
            const f32x4 h0 = (v[0][j] * rs0 * gv[j]) * (1.f + sv[j]) + tv[j], h1 = (v[1][j] * rs1 * gv[j]) * (1.f + sv[j]) + tv[j];
            u32x2 w0, w1; w0.x = pk2(h0[0], h0[1]); w0.y = pk2(h0[2], h0[3]); w1.x = pk2(h1[0], h1[1]); w1.y = pk2(h1[2], h1[3]);
            ((GAS u32x2*)H)[64 * j + lane] = w0; ((GAS u32x2*)(H + D))[64 * j + lane] = w1; }
    }
}

struct GemmJob { const bf16_t* A; const bf16_t* Bt; int K, M, N, epi, crot, skip; bf16_t* o0; bf16_t* o1; int ldc, mode; const f32x2* rope; };

__global__ void __launch_bounds__(512) fwd_kernel(Params p) {
    extern __shared__ __attribute__((aligned(16))) unsigned char lds_raw[];
    LAS unsigned char* lds = (LAS unsigned char*)lds_raw;
    cg::grid_group grid = cg::this_grid();
    const int tid = threadIdx.x, lane = tid & 63, wave = __builtin_amdgcn_readfirstlane(tid >> 6);
    const int G = gridDim.x, bx = blockIdx.x;
    const int vcu = (G % 8 == 0) ? (bx % 8) * (G / 8) + bx / 8 : bx;
    const int gw = vcu * 8 + wave, NGW = G * 8;
    unsigned char* ws = p.ws;
    float* MOD = (float*)(ws + WS_MOD); float* MODP = (float*)(ws + WS_MODP);
    f32x2* ROPEA = (f32x2*)(ws + WS_ROPEA); f32x2* ROPEB = (f32x2*)(ws + WS_ROPEB);
    float* XCTX = (float*)(ws + WS_XCTX); bf16_t* WB = (bf16_t*)(ws + WS_W); bf16_t* HB = (bf16_t*)(ws + WS_H);
    unsigned char* R = ws + WS_R;
    float* OUT = p.out;

    if (bx == 0) { for (int i = tid; i < XCD_BAR_WORDS; i += 512) ((unsigned*)ws)[i] = 0u; }
    if (tid < 4) ((LAS unsigned*)(lds + 131072))[tid] = 0u;
    __syncthreads();
    {
        LAS float* sl = (LAS float*)lds;
        for (int T0 = bx * 512; T0 < 4 * 16 * 1536; T0 += G * 512) {
            const int lkc = T0 / 1536, l = lkc >> 4, kc = lkc & 15, n4 = (T0 - lkc * 1536) + tid;
            __syncthreads();
            if (tid < 320) { const int v = tid >> 6, k = tid & 63; const float cv = (v < 4) ? p.in[1][v * D + kc * 64 + k] : p.in[3][kc * 64 + k]; sl[tid] = cv / (1.f + __expf(-cv)); }
            __syncthreads();
            const float* wm = p.in[4 + (l == 0 ? 0 : (l == 1 ? 9 : (l == 2 ? 20 : 28)))] + (size_t)(kc * 64) * NMOD + n4 * 4;
            f32x4 a0 = {0, 0, 0, 0}, a1 = a0, a2 = a0, a3 = a0, a4 = a0;
#pragma unroll 4
            for (int k = 0; k < 64; ++k) { const f32x4 wv = *(const GAS f32x4*)(wm + (size_t)k * NMOD);
                a0 += sl[k] * wv; a1 += sl[64 + k] * wv; a2 += sl[128 + k] * wv; a3 += sl[192 + k] * wv; a4 += sl[256 + k] * wv; }
            float* mp = MODP + (size_t)(lkc * 5) * NMOD + n4 * 4;
            *(GAS f32x4*)(mp) = a0; *(GAS f32x4*)(mp + NMOD) = a1; *(GAS f32x4*)(mp + 2 * NMOD) = a2; *(GAS f32x4*)(mp + 3 * NMOD) = a3; *(GAS f32x4*)(mp + 4 * NMOD) = a4;
        }
        __syncthreads();
        LAS float* scr = (LAS float*)(lds + wave * 16384);
        int total = 0;
        for (int i = 0; i < p.nmd; ++i) total += p.md[i].nitems;
        for (int it = gw; it < total; it += NGW) {
            int r = it, di = 0;
            while (r >= p.md[di].nitems) { r -= p.md[di].nitems; ++di; }
            transpose_item(p.md[di].src, p.md[di].K, p.md[di].N, WB + p.md[di].dst_off, p.md[di].mode, scr, r, lane);
        }
        { GAS u32x4* z = (GAS u32x4*)(WB + 1 * WL + W_WIN + (size_t)544 * D); const int nz = 224 * D / 8; const u32x4 zz = {0u, 0u, 0u, 0u};
          for (int i = bx * 512 + tid; i < nz; i += G * 512) z[i] = zz; }
        const float l2t = 13.287712379549449f;
        for (int i = bx * 512 + tid; i < SEQ * 32; i += G * 512) { const int t = i >> 5, j = i & 31; const float pv = (j < 16) ? (float)(t >> 6) : (float)(t & 63);
            const float inv = exp2f(-(float)(j & 15) * (1.f / 16.f) * l2t), ang = pv * inv; ROPEA[i] = (f32x2){cosf(ang), sinf(ang)}; }
        for (int i = bx * 512 + tid; i < SEQ * 16; i += G * 512) { const int t = i >> 4, j = i & 15; const float pv = (j < 8) ? (float)(t >> 6) : (float)(t & 63);
            const float inv = exp2f(-(float)(j & 7) * (1.f / 8.f) * l2t), ang = pv * inv; ROPEB[i] = (f32x2){cosf(ang), sinf(ang)}; }
    }
    grid.sync();
    if (tid == 0) (void)xb_add(&((unsigned*)ws)[XB_XCNT(xb_xcc_id())], 1u);
    for (int i = bx * 512 + tid; i < 4 * 5 * NMOD; i += G * 512) {
        const int l = i / (5 * NMOD), rem = i - l * 5 * NMOD, v = rem / NMOD, nn = rem - v * NMOD;
        float s = p.in[5 + (l == 0 ? 0 : (l == 1 ? 9 : (l == 2 ? 20 : 28)))][nn];
#pragma unroll
        for (int kc = 0; kc < 16; ++kc) s += MODP[(size_t)((l * 16 + kc) * 5 + v) * NMOD + nn];
        MOD[i] = s;
    }
    GRID_BAR();
    for (int pr = gw; pr < MTOT / 2; pr += NGW) {
        const int row = 2 * pr;
        const int b = row / TPB, pos = row - b * TPB; const bool isc = pos < CTX;
        const float* src = isc ? p.in[2] + (size_t)(b * CTX + pos) * D : p.in[0] + (size_t)(b * SEQ + pos - CTX) * D;
        float* X = isc ? XCTX + (size_t)(b * CTX + pos) * D : OUT + (size_t)(b * SEQ + pos - CTX) * D;
        const float* md = MOD + (size_t)(isc ? 4 : b) * NMOD;
        row_pass2(lane, src, X, nullptr, nullptr, nullptr, HB + (size_t)row * D, p.in[6], md + D, md);
    }
    GRID_BAR();

#define PHASE_PTRS \
            int sq_ = st; asm volatile("" : "+s"(sq_)); \
            const int l = sq_ / 10, ph = sq_ - l * 10, kind = l % 3; \
            const int ib = (l == 0 ? 4 : (l == 1 ? 13 : (l == 2 ? 24 : 32))); \
            int ln = (int)__builtin_amdgcn_mbcnt_hi(~0u, __builtin_amdgcn_mbcnt_lo(~0u, 0u)); asm volatile("" : "+v"(ln)); int td = wave * 64 + ln; \
            unsigned char* wsl = p.ws; asm volatile("" : "+s"(wsl)); \
            float* MOD = (float*)(wsl + WS_MOD); f32x2* ROPEA = (f32x2*)(wsl + WS_ROPEA); f32x2* ROPEB = (f32x2*)(wsl + WS_ROPEB); \
            float* XCTX = (float*)(wsl + WS_XCTX); bf16_t* HB = (bf16_t*)(wsl + WS_H); \
            unsigned char* R = wsl + WS_R; float* OUT = p.out; \
            const float* gnorm = p.in[ib + 2]; \
            bf16_t* WLp = (bf16_t*)(wsl + WS_W) + (size_t)l * WL; \
            bf16_t* Qb = (bf16_t*)R; \
            bf16_t* Kb = (bf16_t*)(R + (kind == 1 ? 99 : 66) * MiB); \
            bf16_t* Vtb = (bf16_t*)(R + (kind == 1 ? 198 : 132) * MiB); \
            bf16_t* Ob = (bf16_t*)(R + (kind == 1 ? 264 : 198) * MiB); \
            bf16_t* Zb = (bf16_t*)(R + 264 * MiB); \
            bf16_t* CQ = HB; bf16_t* CKV = HB + (size_t)MTOT * 256; \
            bf16_t* Yb = (bf16_t*)R; bf16_t* ACT = (bf16_t*)R; \
            (void)MOD; (void)ROPEA; (void)ROPEB; (void)XCTX; (void)OUT; (void)gnorm; (void)WLp; (void)Qb; (void)Kb; (void)Vtb; (void)Ob; (void)Zb; (void)CQ; (void)CKV; (void)Yb; (void)ACT; (void)ln; (void)td; (void)ib;
#pragma unroll 1
    for (int st = 0; st < 40; ++st) {
        bool did = false;
        {
            PHASE_PTRS
            int njobs = 0;
            if (ph == 0) njobs = (kind == 1) ? 1 : 2;
            else if (ph == 2) njobs = (kind == 1) ? 3 : 0;
            else if (ph == 5 || ph == 7 || ph == 8) njobs = 1;
            did = njobs > 0;
#pragma unroll 1
            for (int j = 0; j < njobs; ++j) {
                GemmJob gj; gj.crot = 0; gj.skip = 0; gj.o1 = nullptr; gj.rope = nullptr; gj.mode = 0; gj.ldc = D; gj.K = D; gj.M = MTOT; gj.N = D; gj.epi = 0; gj.o0 = nullptr; gj.A = HB; gj.Bt = WLp;
                if (ph == 0) {
                    if (kind == 1) { gj.Bt = WLp + W_WIN; gj.N = 768; gj.o0 = Zb; gj.ldc = 768; }
                    else if (j == 0) { gj.Bt = WLp + W_MX; gj.N = 2048; gj.epi = 1; gj.o0 = Qb; gj.o1 = Kb; gj.mode = (kind == 0) ? 0 : 3; gj.rope = ROPEA; }
                    else { gj.A = WLp + W_MX + (size_t)2048 * D; gj.Bt = HB; gj.M = D; gj.N = MTOT; gj.o0 = Vtb; gj.ldc = MTOT; gj.crot = G / 2; }
                } else if (ph == 2) {
                    gj.K = 256;
                    if (j == 0) { gj.A = CQ; gj.Bt = WLp + W_WUQ; gj.N = 1536; gj.epi = 1; gj.o0 = Qb; gj.o1 = Kb; gj.mode = 1; gj.rope = ROPEB; }
                    else if (j == 1) { gj.A = CKV; gj.Bt = WLp + W_WUKV; gj.N = 1024; gj.epi = 1; gj.o0 = Qb; gj.o1 = Kb; gj.mode = 2; gj.crot = G / 4; }
                    else { gj.A = WLp + W_WUKV + (size_t)1024 * 256; gj.Bt = CKV; gj.M = 1024; gj.N = MTOT; gj.o0 = Vtb; gj.ldc = MTOT; gj.crot = G / 2; }
                } else if (ph == 5) { gj.A = (kind == 0) ? HB : Ob; gj.Bt = WLp + W_WO; gj.o0 = Yb; }
                else if (ph == 7) { gj.Bt = WLp + W_GU; gj.N = 2 * FF; gj.epi = 2; gj.o0 = ACT; }
                else { gj.A = ACT; gj.Bt = WLp + W_DN; gj.K = FF; gj.o0 = HB; }
                if (l == 3 && ph >= 5) { gj.M = NB * SEQ; gj.skip = 1; }
                pg8::StaticOrder S; S.init(gj.M, gj.N, G, (bx + gj.crot) % G, gj.skip);
                const pg8::Gemm gg{gj.A, gj.Bt, gj.K};
                if (gj.epi == 0) { EpiStore E{gj.o0, gj.ldc}; pg8::gemm_phase<EpiStore, pg8::StaticOrder>(lds, gg, S, E, td); }
                else if (gj.epi == 1) { EpiQK E{gj.o0, (long long)(gj.o1 - gj.o0), gj.rope, gj.mode, ((gj.mode == 1) ? 0.10206207261596577f : 0.125f) * LOG2E}; pg8::gemm_phase<EpiQK, pg8::StaticOrder>(lds, gg, S, E, td); }
                else { EpiSwiGLU E{gj.o0}; pg8::gemm_phase<EpiSwiGLU, pg8::StaticOrder>(lds, gg, S, E, td); }
            }
        }
        {
            PHASE_PTRS
            if (ph == 1 && kind == 1) {
                did = true;
                const float* gq = p.in[19]; const float* gkv = p.in[20];
                for (int row = gw; row < MTOT; row += NGW) {
                    const int b = row / TPB, pos = row - b * TPB;
                    const bf16_t* z = Zb + (size_t)row * 768;
                    const u32x2 rq = ((const GAS u32x2*)z)[ln], rk = ((const GAS u32x2*)(z + 256))[ln];
                    f32x4 q4 = {bflo(rq.x), bfhi(rq.x), bflo(rq.y), bfhi(rq.y)}, k4 = {bflo(rk.x), bfhi(rk.x), bflo(rk.y), bfhi(rk.y)};
                    const float sq = wave_sum((q4[0] * q4[0] + q4[1] * q4[1]) + (q4[2] * q4[2] + q4[3] * q4[3]));
                    const float sk = wave_sum((k4[0] * k4[0] + k4[1] * k4[1]) + (k4[2] * k4[2] + k4[3] * k4[3]));
                    const float rq_ = rsqrtf(sq * (1.f / 256.f) + EPS), rk_ = rsqrtf(sk * (1.f / 256.f) + EPS);
                    const f32x4 g1 = ((const GAS f32x4*)gq)[ln], g2 = ((const GAS f32x4*)gkv)[ln];
                    q4 = q4 * rq_ * g1; k4 = k4 * rk_ * g2;
                    u32x2 wq; wq.x = pk2(q4[0], q4[1]); wq.y = pk2(q4[2], q4[3]); ((GAS u32x2*)(CQ + (size_t)row * 256))[ln] = wq;
                    u32x2 wk; wk.x = pk2(k4[0], k4[1]); wk.y = pk2(k4[2], k4[3]); ((GAS u32x2*)(CKV + (size_t)row * 256))[ln] = wk;
                    const int i = ln & 15;
                    const float t1 = bflo((unsigned)z[512 + i]), t2 = bflo((unsigned)z[528 + i]);
                    float o1 = t1, o2 = t2;
                    if (pos >= CTX) { const f32x2 cs = ROPEB[(size_t)(pos - CTX) * 16 + i]; o1 = t1 * cs[0] - t2 * cs[1]; o2 = t1 * cs[1] + t2 * cs[0]; }
                    const int part = ln & 3, head = ln >> 2;
                    float e[8];
#pragma unroll
                    for (int jj = 0; jj < 8; ++jj) { const int srcl = (8 * part + jj) & 15; const float v1 = __shfl(o1, srcl), v2 = __shfl(o2, srcl); e[jj] = (part < 2) ? v1 : v2; }
                    u32x4 wv; wv.x = pk2(e[0], e[1]); wv.y = pk2(e[2], e[3]); wv.z = pk2(e[4], e[5]); wv.w = pk2(e[6], e[7]);
                    *(GAS u32x4*)(Kb + ((size_t)(b * 16 + head) * TPB + pos) * 96 + 64 + 8 * part) = wv;
                }
            }
            if (ph == 3) {
                did = true;
                if (kind == 0) {
                    const float* lam_v = p.in[ib + 7];
                    const float lam_init = (l == 0) ? 0.2f : 0.5560582042f;
                    const float sa = wave_sum(lam_v[ln] * lam_v[64 + ln]), sb = wave_sum(lam_v[128 + ln] * lam_v[192 + ln]);
                    const float lam = expf(sa) - expf(sb) + lam_init;
                    attn_phase<64, 128, 0, 1, 1>(lds, Qb, Kb, Vtb, Ob, 2048, 0.125f, nullptr, vcu, G, td, HB, p.in[ib + 8], lam, 1.f - lam_init);
                }
                else if (kind == 1) attn_phase<96, 64, 0, 0, 0>(lds, Qb, Kb, Vtb, Ob, 1024, 0.10206207261596577f, nullptr, vcu, G, td, nullptr, nullptr, 0.f, 0.f);
                else attn_phase<64, 64, 1, 0, 0>(lds, Qb, Kb, Vtb, Ob, 1024, 0.125f, p.in[30], vcu, G, td, nullptr, nullptr, 0.f, 0.f);
            }
            if (false) {
                did = true;
                const float* lam_v = p.in[ib + 7]; const float* gsub = p.in[ib + 8];
                const float lam_init = (l == 0) ? 0.2f : 0.5560582042f;
                const float sa = wave_sum(lam_v[ln] * lam_v[64 + ln]), sb = wave_sum(lam_v[128 + ln] * lam_v[192 + ln]);
                const float lam = expf(sa) - expf(sb) + lam_init;
                const int head = ln >> 3, e0 = (ln & 7) * 16;
                float gs[16];
#pragma unroll
                for (int i = 0; i < 16; ++i) gs[i] = gsub[e0 + i] * (1.f - lam_init);
                for (int row = gw; row < MTOT; row += NGW) {
                    const bf16_t* o1p = Ob + (size_t)row * 2048 + (2 * head) * 128 + e0;
                    const u32x4 a0 = ((const GAS u32x4*)o1p)[0], a1 = ((const GAS u32x4*)o1p)[1], b0 = ((const GAS u32x4*)(o1p + 128))[0], b1 = ((const GAS u32x4*)(o1p + 128))[1];
                    float d[16];
#pragma unroll
                    for (int i = 0; i < 4; ++i) { d[2 * i] = bflo(a0[i]) - lam * bflo(b0[i]); d[2 * i + 1] = bfhi(a0[i]) - lam * bfhi(b0[i]);
                        d[8 + 2 * i] = bflo(a1[i]) - lam * bflo(b1[i]); d[8 + 2 * i + 1] = bfhi(a1[i]) - lam * bfhi(b1[i]); }
                    float ss = 0.f;
#pragma unroll
                    for (int i = 0; i < 16; ++i) ss += d[i] * d[i];
                    ss += __shfl_xor(ss, 1); ss += __shfl_xor(ss, 2); ss += __shfl_xor(ss, 4);
                    const float rs = rsqrtf(ss * (1.f / 128.f) + EPS);
                    u32x4 w0, w1;
                    w0.x = pk2(d[0] * rs * gs[0], d[1] * rs * gs[1]); w0.y = pk2(d[2] * rs * gs[2], d[3] * rs * gs[3]); w0.z = pk2(d[4] * rs * gs[4], d[5] * rs * gs[5]); w0.w = pk2(d[6] * rs * gs[6], d[7] * rs * gs[7]);
                    w1.x = pk2(d[8] * rs * gs[8], d[9] * rs * gs[9]); w1.y = pk2(d[10] * rs * gs[10], d[11] * rs * gs[11]); w1.z = pk2(d[12] * rs * gs[12], d[13] * rs * gs[13]); w1.w = pk2(d[14] * rs * gs[14], d[15] * rs * gs[15]);
                    GAS u32x4* hp = (GAS u32x4*)(HB + (size_t)row * D + head * 128 + e0); hp[0] = w0; hp[1] = w1;
                }
            }
            if (ph == 6 || ph == 9) {
                did = true;
                const bool first = (ph == 6);
                const bool has_h = first || l < 3;
                const int ibn = (l == 0 ? 13 : (l == 1 ? 24 : 32));
                for (int pr = gw; pr < MTOT / 2; pr += NGW) {
                    const int row = 2 * pr;
                    const int b = row / TPB, pos = row - b * TPB; const bool isc = pos < CTX;
                    if (l == 3 && isc) continue;
                    float* X = isc ? XCTX + (size_t)(b * CTX + pos) * D : OUT + (size_t)(b * SEQ + pos - CTX) * D;
                    const float* md = MOD + (size_t)(l * 5 + (isc ? 4 : b)) * NMOD;
                    const float* mdn = MOD + (size_t)((l + 1) * 5 + (isc ? 4 : b)) * NMOD;
                    if (first) row_pass2(ln, X, X, Yb + (size_t)row * D, gnorm + D, md + 2 * D, HB + (size_t)row * D, gnorm + 2 * D, md + 4 * D, md + 3 * D);
                    else row_pass2(ln, X, X, HB + (size_t)row * D, gnorm + 3 * D, md + 5 * D, has_h ? HB + (size_t)row * D : nullptr, has_h ? p.in[ibn + 2] : nullptr, mdn + D, mdn);
                }
            }
        }
        if (did) GRID_BAR();
    }
}

constexpr int LDS_BYTES = 132 * 1024;
extern "C" void kernel_launch(void* const* d_in, const int* in_sizes, int n_in, void* d_out, int out_size, void* d_ws, size_t ws_size, hipStream_t stream) {
    static int grid_blocks = 0;
    if (grid_blocks == 0) {
        if (n_in != 41 || ws_size < WS_END) { fprintf(stderr, "kernel_launch: unexpected n_in %d or ws %zu (need %zu)\n", n_in, ws_size, (size_t)WS_END); grid_blocks = -1; return; }
        int dev = 0, cus = 0, per_cu = 0;
        hipGetDevice(&dev);
        hipDeviceGetAttribute(&cus, hipDeviceAttributeMultiprocessorCount, dev);
        if (hipFuncSetAttribute((const void*)fwd_kernel, hipFuncAttributeMaxDynamicSharedMemorySize, LDS_BYTES) != hipSuccess) { fprintf(stderr, "kernel_launch: hipFuncSetAttribute failed\n"); }
        if (hipOccupancyMaxActiveBlocksPerMultiprocessor(&per_cu, (const void*)fwd_kernel, 512, LDS_BYTES) != hipSuccess || per_cu < 1) { fprintf(stderr, "kernel_launch: occupancy query gave %d\n", per_cu); per_cu = 1; }
        (void)hipGetLastError();
        grid_blocks = cus * 1;
    }
    if (grid_blocks < 0) return;
    Params p{};
    for (int i = 0; i < 41; ++i) p.in[i] = (const float*)d_in[i];
    p.out = (float*)d_out; p.ws = (unsigned char*)d_ws;
    int nm = 0;
    auto add = [&](int idx, long long off, int K, int N, int mode) { MatDesc& m = p.md[nm++]; m.src = (const float*)d_in[idx]; m.dst_off = off; m.K = K; m.N = N; m.mode = mode; m.nitems = (K / 64) * (N / 32); };
    const int ibs[4] = {4, 13, 24, 32};
    for (int l = 0; l < 4; ++l) {
        const long long base = (long long)l * WL; const int ib = ibs[l], kind = l % 3;
        add(ib + 3, base + W_GU, D, 2 * FF, 2);
        add(ib + 4, base + W_DN, FF, D, 0);
        if (kind == 0) { add(ib + 5, base + W_MX, D, 3 * D, 1); add(ib + 6, base + W_WO, D, D, 0); }
        else if (kind == 1) { add(ib + 5, base + W_WIN, D, 544, 0); add(ib + 8, base + W_WUQ, 256, 1536, 3); add(ib + 9, base + W_WUKV, 256, 2048, 4); add(ib + 10, base + W_WO, D, D, 0); }
        else { add(ib + 5, base + W_MX, D, 3 * D, 0); add(ib + 7, base + W_WO, D, D, 0); }
    }
    p.nmd = nm; p.pad = 0;
    void* args[] = {&p};
    hipError_t e = hipLaunchCooperativeKernel((const void*)fwd_kernel, dim3(grid_blocks), dim3(512), args, LDS_BYTES, stream);
    if (e != hipSuccess) fprintf(stderr, "cooperative launch failed: %s (grid %d)\n", hipGetErrorString(e), grid_blocks);
}
```
